# Optimizing an MI355X kernel written in HIP

```python
import math, functools
import jax, jax.numpy as jnp
from jax import lax
import numpy as np

D_MODEL = 1024
BATCH = 2
SEQ = 8192
DEPTH = 2

ATT_HEADS = 8
ATT_HEAD_DIM = 64
ATT_WIDTH = ATT_HEADS * ATT_HEAD_DIM
ATT_PATTERNS = ((128, 1), (512, 4), (2048, 16))
ATT_BLOCK = 128
SSD_HEADS = 8
SSD_HEAD_DIM = 64
SSD_WIDTH = SSD_HEADS * SSD_HEAD_DIM
SSD_GROUPS = 2
SSD_STATE = 128
SSD_CHUNK = 128
SSD_CONV_CH = SSD_WIDTH + 2 * SSD_GROUPS * SSD_STATE
DT_MIN = 0.001
DT_MAX = 0.1
LRU_WIDTH = 512
LRU_BLOCKS = 8
LRU_BLOCK_W = LRU_WIDTH // LRU_BLOCKS
LRU_C = 8.0
CONV_WIDTH = 4
D_MIX = ATT_WIDTH + SSD_WIDTH + LRU_WIDTH
IN_COLS = 3 * ATT_WIDTH + SSD_WIDTH + SSD_CONV_CH + SSD_HEADS + 2 * LRU_WIDTH
D_FF = ((8 * D_MODEL + 3 * 256 - 1) // (3 * 256)) * 256
NORM_EPS = 1e-6
SSD_NORM_EPS = 1e-5

kernel_name = 'hybrid_dilated_attn_ssd_rglru_block'


def rmsnorm(x, g, eps=NORM_EPS):
    xf = x.astype(jnp.float32)
    y = xf * lax.rsqrt(jnp.mean(xf * xf, axis=-1, keepdims=True) + eps)
    return (y * g.astype(jnp.float32)).astype(x.dtype)


def causal_depthwise_conv(x, w, b):
    k_width, s = w.shape[0], x.shape[1]
    xp = jnp.pad(x, ((0, 0), (k_width - 1, 0), (0, 0)))
    y = b + xp[:, k_width - 1:] * w[k_width - 1]
    for k in range(k_width - 1):
        y = y + xp[:, k:k + s] * w[k]
    return y


def split_cols(proj):
    sizes = (ATT_WIDTH, ATT_WIDTH, ATT_WIDTH, SSD_WIDTH, SSD_CONV_CH, SSD_HEADS, LRU_WIDTH, LRU_WIDTH)
    offsets = np.cumsum(sizes)[:-1].tolist()
    return jnp.split(proj, offsets, axis=-1)


def dilated_branch(q, k, v, window, dilation, slopes):
    b, s, h, dh = q.shape
    length = s // dilation
    nb = -(-length // ATT_BLOCK)
    pad = nb * ATT_BLOCK - length

    def to_blocks(t):
        t = t.reshape(b, length, dilation, h, dh).transpose(0, 2, 3, 1, 4)
        t = jnp.pad(t, ((0, 0), (0, 0), (0, 0), (0, pad), (0, 0)))
        return t.reshape(b, dilation, h, nb, ATT_BLOCK, dh)

    def with_prev(t):
        prev = jnp.pad(t[:, :, :, :-1], ((0, 0), (0, 0), (0, 0), (1, 0), (0, 0), (0, 0)))
        return jnp.concatenate([prev, t], axis=4)

    qb, kb, vb = to_blocks(q), to_blocks(k), to_blocks(v)
    kk, vv = with_prev(kb), with_prev(vb)
    scores = jnp.einsum('brhnqd,brhnkd->brhnqk', qb, kk,
                        preferred_element_type=jnp.float32) * (ATT_HEAD_DIM ** -0.5)
    qi = jnp.arange(ATT_BLOCK)[:, None]
    ki = jnp.arange(2 * ATT_BLOCK)[None, :]
    dist = ATT_BLOCK + qi - ki
    band = (dist >= 0) & (dist <= window // dilation)
    valid = band[None] & ((jnp.arange(nb)[:, None, None] > 0) | (ki[None] >= ATT_BLOCK))
    alibi = -slopes[:, None, None] * (dilation * dist).astype(jnp.float32)
    scores = scores + alibi[None, None, :, None]
    scores = jnp.where(valid[None, None, None], scores, -jnp.inf)
    m = jnp.max(scores, axis=-1)
    p = jnp.exp(scores - m[..., None])
    den = jnp.sum(p, axis=-1)
    num = jnp.einsum('brhnqk,brhnkd->brhnqd', p, vv.astype(jnp.float32))

    def from_blocks(t):
        t = t.reshape(b, dilation, h, nb * ATT_BLOCK, *t.shape[5:])[:, :, :, :length]
        t = jnp.moveaxis(t, 3, 1)
        return t.reshape(b, s, h, *t.shape[4:])

    return from_blocks(num), from_blocks(m), from_blocks(den)


def dilated_attention(q, k, v):
    b, s, _ = q.shape
    shp = (b, s, ATT_HEADS, ATT_HEAD_DIM)
    q, k, v = q.reshape(shp), k.reshape(shp), v.reshape(shp)
    slopes = jnp.exp2(-8.0 * jnp.arange(1, ATT_HEADS + 1, dtype=jnp.float32) / ATT_HEADS)
    branches = [dilated_branch(q, k, v, w, d, slopes) for (w, d) in ATT_PATTERNS]
    m_all = functools.reduce(jnp.maximum, [br[1] for br in branches])
    num = jnp.zeros(shp, jnp.float32)
    den = jnp.zeros(shp[:3], jnp.float32)
    for n_g, m_g, d_g in branches:
        e = jnp.exp(m_g - m_all)
        num = num + n_g * e[..., None]
        den = den + d_g * e
    return (num / den[..., None]).reshape(b, s, ATT_WIDTH)


def ssd_chunked_scan(x, dt, a, bm, cm):
    b, s, h, p = x.shape
    n = bm.shape[-1]
    q = SSD_CHUNK
    nc = s // q
    rep = h // bm.shape[2]
    x = x.reshape(b, nc, q, h, p)
    dt = dt.reshape(b, nc, q, h)
    bh = jnp.repeat(bm, rep, axis=2).reshape(b, nc, q, h, n)
    ch = jnp.repeat(cm, rep, axis=2).reshape(b, nc, q, h, n)
    acs = jnp.cumsum(dt * a, axis=2)
    seg = acs[:, :, :, None, :] - acs[:, :, None, :, :]
    causal = jnp.tril(jnp.ones((q, q), dtype=bool))[None, None, :, :, None]
    lmat = jnp.exp(jnp.where(causal, seg, -jnp.inf))
    scores = jnp.einsum('bcihn,bcjhn->bcijh', ch, bh) * lmat * dt[:, :, None, :, :]
    y_diag = jnp.einsum('bcijh,bcjhp->bcihp', scores, x)
    decay_to_end = jnp.exp(acs[:, :, -1:, :] - acs)
    states = jnp.einsum('bcjhn,bcjh,bcjhp->bchpn', bh, decay_to_end * dt, x)
    chunk_decay = jnp.exp(acs[:, :, -1, :])

    def step(carry, inp):
        st, dc = inp
        return dc[:, :, None, None] * carry + st, carry

    _, prev = lax.scan(step, jnp.zeros((b, h, p, n), x.dtype),
                       (jnp.moveaxis(states, 1, 0), jnp.moveaxis(chunk_decay, 1, 0)))
    prev = jnp.moveaxis(prev, 0, 1)
    y_off = jnp.einsum('bcihn,bchpn,bcih->bcihp', ch, prev, jnp.exp(acs))
    return (y_diag + y_off).reshape(b, s, h, p)


def ssd_mixer(z, xbc, dt_raw, conv_w, conv_b, dt_bias, a_log, d_skip, norm_w):
    b, s, _ = z.shape
    f32 = jnp.float32
    xbc = jax.nn.silu(causal_depthwise_conv(xbc, conv_w, conv_b)).astype(f32)
    xs, bm, cm = jnp.split(xbc, [SSD_WIDTH, SSD_WIDTH + SSD_GROUPS * SSD_STATE], axis=-1)
    xs = xs.reshape(b, s, SSD_HEADS, SSD_HEAD_DIM)
    bm = bm.reshape(b, s, SSD_GROUPS, SSD_STATE)
    cm = cm.reshape(b, s, SSD_GROUPS, SSD_STATE)
    dt = jax.nn.softplus(dt_raw.astype(f32) + dt_bias.astype(f32))
    a = -jnp.exp(a_log.astype(f32))
    y = ssd_chunked_scan(xs, dt, a, bm, cm) + d_skip.astype(f32)[:, None] * xs
    y = y.reshape(b, s, SSD_WIDTH) * jax.nn.silu(z.astype(f32))
    yg = y.reshape(b, s, SSD_GROUPS, SSD_WIDTH // SSD_GROUPS)
    yg = yg * lax.rsqrt(jnp.mean(yg * yg, axis=-1, keepdims=True) + SSD_NORM_EPS)
    return yg.reshape(b, s, SSD_WIDTH) * norm_w.astype(f32)


def rglru_mixer(gate_in, x_in, conv_w, conv_b, wa, ba, wx, bx, lam):
    b, s, _ = x_in.shape
    f32 = jnp.float32
    gate = jax.nn.gelu(gate_in.astype(f32))
    xc = causal_depthwise_conv(x_in, conv_w, conv_b).astype(f32)
    xb = xc.reshape(b, s, LRU_BLOCKS, LRU_BLOCK_W)
    r = jax.nn.sigmoid(jnp.einsum('bsnc,ncd->bsnd', xb, wa.astype(f32)).reshape(b, s, LRU_WIDTH) + ba.astype(f32))
    i = jax.nn.sigmoid(jnp.einsum('bsnc,ncd->bsnd', xb, wx.astype(f32)).reshape(b, s, LRU_WIDTH) + bx.astype(f32))
    log_a = -LRU_C * r * jax.nn.softplus(-lam.astype(f32))
    a = jnp.exp(log_a)
    u = jnp.sqrt(-jnp.expm1(2.0 * log_a)) * (i * xc)

    def combine(left, right):
        a_l, h_l = left
        a_r, h_r = right
        return a_l * a_r, a_r * h_l + h_r

    _, h = lax.associative_scan(combine, (a, u), axis=1)
    return h * gate


def swiglu(h, w_gate, w_up, w_down):
    return (jax.nn.silu(h @ w_gate) * (h @ w_up)) @ w_down


def hybrid_layer(x, norm_mix, w_in, ssd_conv_w, ssd_conv_b, ssd_dt_bias, ssd_a_log, ssd_d, ssd_norm,
                 lru_conv_w, lru_conv_b, lru_wa, lru_ba, lru_wx, lru_bx, lru_lambda, w_out,
                 norm_ffn, w_gate, w_up, w_down):
    h = rmsnorm(x, norm_mix)
    q, k, v, z, xbc, dt_raw, g_lru, x_lru = split_cols(h @ w_in)
    att = dilated_attention(q, k, v).astype(x.dtype)
    ssd = ssd_mixer(z, xbc, dt_raw, ssd_conv_w, ssd_conv_b, ssd_dt_bias, ssd_a_log, ssd_d, ssd_norm).astype(x.dtype)
    lru = rglru_mixer(g_lru, x_lru, lru_conv_w, lru_conv_b, lru_wa, lru_ba, lru_wx, lru_bx, lru_lambda).astype(x.dtype)
    x = x + jnp.concatenate([att, ssd, lru], axis=-1) @ w_out
    x = x + swiglu(rmsnorm(x, norm_ffn), w_gate, w_up, w_down)
    return x


def setup_inputs(seed: int = 0) -> dict:
    key = jax.random.key(seed)
    ks = jax.random.split(key, 24)
    f32 = jnp.float32
    L = DEPTH

    def nrm(k, shape, scale):
        return scale * jax.random.normal(k, shape, f32)

    x = nrm(ks[0], (BATCH, SEQ, D_MODEL), 1.0)
    norm_mix = 1.0 + nrm(ks[1], (L, D_MODEL), 0.05)
    w_in = nrm(ks[2], (L, D_MODEL, IN_COLS), D_MODEL ** -0.5)
    ssd_conv_w = nrm(ks[3], (L, CONV_WIDTH, SSD_CONV_CH), CONV_WIDTH ** -0.5)
    ssd_conv_b = nrm(ks[4], (L, SSD_CONV_CH), 0.02)
    dt0 = jnp.exp(jax.random.uniform(ks[5], (L, SSD_HEADS), f32, math.log(DT_MIN), math.log(DT_MAX)))
    ssd_dt_bias = dt0 + jnp.log(-jnp.expm1(-dt0))
    ssd_a_log = jnp.log(jax.random.uniform(ks[6], (L, SSD_HEADS), f32, 1.0, 16.0))
    ssd_d = 1.0 + nrm(ks[7], (L, SSD_HEADS), 0.1)
    ssd_norm = 1.0 + nrm(ks[8], (L, SSD_WIDTH), 0.05)
    lru_conv_w = nrm(ks[9], (L, CONV_WIDTH, LRU_WIDTH), CONV_WIDTH ** -0.5)
    lru_conv_b = nrm(ks[10], (L, LRU_WIDTH), 0.02)
    lru_wa = nrm(ks[11], (L, LRU_BLOCKS, LRU_BLOCK_W, LRU_BLOCK_W), LRU_BLOCK_W ** -0.5)
    lru_ba = nrm(ks[12], (L, LRU_WIDTH), 0.02)
    lru_wx = nrm(ks[13], (L, LRU_BLOCKS, LRU_BLOCK_W, LRU_BLOCK_W), LRU_BLOCK_W ** -0.5)
    lru_bx = nrm(ks[14], (L, LRU_WIDTH), 0.02)
    a_c = jax.random.uniform(ks[15], (L, LRU_WIDTH), f32, 0.9, 0.999)
    a_base = a_c ** (1.0 / LRU_C)
    lru_lambda = jnp.log(a_base) - jnp.log1p(-a_base)
    w_out = nrm(ks[16], (L, D_MIX, D_MODEL), D_MIX ** -0.5)
    norm_ffn = 1.0 + nrm(ks[17], (L, D_MODEL), 0.05)
    w_gate = nrm(ks[18], (L, D_MODEL, D_FF), D_MODEL ** -0.5)
    w_up = nrm(ks[19], (L, D_MODEL, D_FF), D_MODEL ** -0.5)
    w_down = nrm(ks[20], (L, D_FF, D_MODEL), D_FF ** -0.5)
    norm_final = 1.0 + nrm(ks[21], (D_MODEL,), 0.05)
    return {'x': x, 'norm_mix': norm_mix, 'w_in': w_in, 'ssd_conv_w': ssd_conv_w, 'ssd_conv_b': ssd_conv_b,
            'ssd_dt_bias': ssd_dt_bias, 'ssd_a_log': ssd_a_log, 'ssd_d': ssd_d, 'ssd_norm': ssd_norm,
            'lru_conv_w': lru_conv_w, 'lru_conv_b': lru_conv_b, 'lru_wa': lru_wa, 'lru_ba': lru_ba,
            'lru_wx': lru_wx, 'lru_bx': lru_bx, 'lru_lambda': lru_lambda, 'w_out': w_out,
            'norm_ffn': norm_ffn, 'w_gate': w_gate, 'w_up': w_up, 'w_down': w_down, 'norm_final': norm_final}


def reference(x, norm_mix, w_in, ssd_conv_w, ssd_conv_b, ssd_dt_bias, ssd_a_log, ssd_d, ssd_norm,
              lru_conv_w, lru_conv_b, lru_wa, lru_ba, lru_wx, lru_bx, lru_lambda, w_out,
              norm_ffn, w_gate, w_up, w_down, norm_final):
    for l in range(DEPTH):
        x = hybrid_layer(x, norm_mix[l], w_in[l], ssd_conv_w[l], ssd_conv_b[l], ssd_dt_bias[l], ssd_a_log[l],
                         ssd_d[l], ssd_norm[l], lru_conv_w[l], lru_conv_b[l], lru_wa[l], lru_ba[l],
                         lru_wx[l], lru_bx[l], lru_lambda[l], w_out[l], norm_ffn[l], w_gate[l], w_up[l], w_down[l])
    return rmsnorm(x, norm_final)
```

```cpp
#include <hip/hip_runtime.h>
#include <hip/hip_cooperative_groups.h>
#include <cstdio>
#include <cstdint>
namespace cg = cooperative_groups;
namespace pg8 {
#define PG8_LAS __attribute__((address_space(3)))
typedef unsigned short bf16_t;
typedef short bf16x8 __attribute__((ext_vector_type(8)));
typedef float f32x4 __attribute__((ext_vector_type(4)));
typedef unsigned u32x4 __attribute__((ext_vector_type(4)));
constexpr int BM = 256, BK = 64, HALF = 128, HTB = HALF * BK * 2  , STAGE_BYTES = 8 * HTB, NXCD = 8, WGM = 8;

__host__ __device__ __forceinline__ int lds_byte(int r, int c) { const int st = (r >> 4) * 2 + (c >> 5), rr = r & 15, cc = c & 31, ob = rr * 64 + cc * 2; return st * 1024 + (ob ^ (((ob >> 9) & 1) << 5)); }
__host__ __device__ __forceinline__ void stage_rc(int b, int& R, int& C) { const int st = b / 1024, sb = b % 1024, swz = sb ^ (((sb >> 9) & 1) << 5); R = (st >> 1) * 16 + swz / 64; C = (st & 1) * 32 + (swz % 64) / 2; }
__host__ __device__ __forceinline__ int perm32(int rho) { const int n = rho >> 4, i = rho & 15; return 8 * (i >> 2) + 4 * n + (i & 3); }

struct Unit { int pm, pn; };
struct Gemm { const bf16_t* A; const bf16_t* Bt; int M, N, K; };

struct StaticOrder {
    int nM, nN, nwg, G, c;
    __host__ __device__ void init(int M, int N, int G_, int c_) { nM = M / BM; nN = N / BM; nwg = nM * nN; G = G_; c = c_; }
    __host__ __device__ bool next(int i, Unit& u) const {
        const long L = (long)i * G + c; if (L >= nwg) return false;
        int wgid = (int)L; { const int q = nwg / NXCD, r = nwg % NXCD, xcd = wgid % NXCD, off = wgid / NXCD; wgid = (xcd < r ? xcd * (q + 1) : r * (q + 1) + (xcd - r) * q) + off; }
        const int nig = WGM * nN, gid = wgid / nig, fm = gid * WGM, gsz = (nM - fm) < WGM ? (nM - fm) : WGM;
        u.pm = fm + ((wgid % nig) % gsz); u.pn = (wgid % nig) / gsz; return true;
    }
    __device__ __forceinline__ void a_ready(const Unit&) const {}
    __device__ __forceinline__ void done(const Unit&) const {}
};

__device__ __forceinline__ unsigned cvt_pk_bf16(float lo, float hi) { unsigned r; asm volatile("v_cvt_pk_bf16_f32 %0, %1, %2" : "=v"(r) : "v"(lo), "v"(hi)); return r; }
typedef float f32x2 __attribute__((ext_vector_type(2)));
__device__ __forceinline__ f32x2 gelu_pk(f32x2 v) {
    const f32x2 av = __builtin_elementwise_abs(v), d = av * 0.2316418882f + 1.0f;
    f32x2 t; t.x = __builtin_amdgcn_rcpf(d.x); t.y = __builtin_amdgcn_rcpf(d.y);
    f32x2 q = t * 0.5307027145f + (-0.7265760135f); q = q * t + 0.7107068705f; q = q * t + (-0.142248368f); q = q * t + 0.127414796f; q = q * t;
    const f32x2 s = (v * v) * (-0.72134752044f);
    f32x2 e; e.x = __builtin_amdgcn_exp2f(s.x); e.y = __builtin_amdgcn_exp2f(s.y);
    const f32x2 m = v * (q * e), r = v - m;
    f32x2 o; o.x = v.x < 0.f ? m.x : r.x; o.y = v.y < 0.f ? m.y : r.y; return o;
}

template <int ACT  > struct EpiBf16 {
    static constexpr bool PERM = true, AFTER_DRAIN = false; static_assert(ACT == 0 || ACT == 1, "EpiBf16: ACT is 0 (none) or 1 (gelu_pk)");
    bf16_t* O; int ldc; const float* bias; int split_cols; size_t split_stride; float scale0;
    __device__ __forceinline__ void operator()(const f32x4 (&acc)[2][2][4][2], const Unit& u, int wr, int wc, int fr, int fq) const {
        const int row0 = u.pm * BM + wr * 64 + fr; int colt = u.pn * BM; bf16_t* base = O;
        float sc = 1.f; if (split_cols) { const int t = colt / split_cols; base += (size_t)t * split_stride; colt -= t * split_cols; if (t == 0) sc = scale0; }
        const int col0 = colt + wc * 32 + 8 * fq, bcol0 = u.pn * BM + wc * 32 + 8 * fq;
        f32x4 bv[2][2];
#pragma unroll
        for (int bj = 0; bj < 2; ++bj)
#pragma unroll
            for (int n = 0; n < 2; ++n) bv[bj][n] = bias ? *(const f32x4*)(bias + bcol0 + bj * HALF + 4 * n) : (f32x4){0.f, 0.f, 0.f, 0.f};
#pragma unroll
        for (int ai = 0; ai < 2; ++ai)
#pragma unroll
            for (int m = 0; m < 4; ++m) { bf16_t* rowp = base + (size_t)(row0 + ai * HALF + m * 16) * ldc + col0;
#pragma unroll
                for (int bj = 0; bj < 2; ++bj) { f32x4 v0 = acc[ai][bj][m][0] + bv[bj][0], v1 = acc[ai][bj][m][1] + bv[bj][1];
                    if (ACT == 1) { f32x2 a = gelu_pk((f32x2){v0[0], v0[1]}), b = gelu_pk((f32x2){v0[2], v0[3]}), c = gelu_pk((f32x2){v1[0], v1[1]}), d = gelu_pk((f32x2){v1[2], v1[3]});
                        v0 = (f32x4){a.x, a.y, b.x, b.y}; v1 = (f32x4){c.x, c.y, d.x, d.y}; }
                    v0 = v0 * sc; v1 = v1 * sc; u32x4 w; w.x = cvt_pk_bf16(v0[0], v0[1]); w.y = cvt_pk_bf16(v0[2], v0[3]); w.z = cvt_pk_bf16(v1[0], v1[1]); w.w = cvt_pk_bf16(v1[2], v1[3]);
                    *(u32x4*)(rowp + bj * HALF) = w; } }
    }
};
struct EpiResF32 {
    static constexpr bool PERM = false, AFTER_DRAIN = false;
    const float* base; float* out; int ldc;
    __device__ __forceinline__ void operator()(const f32x4 (&acc)[2][2][4][2], const Unit& u, int wr, int wc, int fr, int fq) const {
        const int row0 = u.pm * BM + wr * 64 + fr, col0 = u.pn * BM + wc * 32 + 4 * fq;
#pragma unroll
        for (int ai = 0; ai < 2; ++ai)
#pragma unroll
            for (int m = 0; m < 4; ++m) { const size_t off = (size_t)(row0 + ai * HALF + m * 16) * ldc + col0;
#pragma unroll
                for (int bj = 0; bj < 2; ++bj)
#pragma unroll
                    for (int n = 0; n < 2; ++n) { const f32x4 b = *(const f32x4*)(base + off + bj * HALF + n * 16); *(f32x4*)(out + off + bj * HALF + n * 16) = b + acc[ai][bj][m][n]; } }
    }
};
struct EpiSwiGLU {
    static constexpr bool PERM = true, AFTER_DRAIN = false;
    bf16_t* O; int ldc;
    __device__ __forceinline__ void operator()(const f32x4 (&acc)[2][2][4][2], const Unit& u, int wr, int wc, int fr, int fq) const {
        const int row0 = u.pm * BM + wr * 64 + fr, f0 = u.pn * 128 + wc * 32 + 8 * fq;
#pragma unroll
        for (int ai = 0; ai < 2; ++ai)
#pragma unroll
            for (int m = 0; m < 4; ++m) { bf16_t* rowp = O + (size_t)(row0 + ai * HALF + m * 16) * ldc + f0;
                float r[8];
#pragma unroll
                for (int n = 0; n < 2; ++n)
#pragma unroll
                    for (int e = 0; e < 4; ++e) { const float g = acc[ai][0][m][n][e], up = acc[ai][1][m][n][e]; r[4 * n + e] = g * up * __builtin_amdgcn_rcpf(1.0f + __expf(-g)); }
                u32x4 w; w.x = cvt_pk_bf16(r[0], r[1]); w.y = cvt_pk_bf16(r[2], r[3]); w.z = cvt_pk_bf16(r[4], r[5]); w.w = cvt_pk_bf16(r[6], r[7]);
                *(u32x4*)rowp = w; }
    }
};
template <class Epi, class Sched, bool ALIGN_EPI = false, bool SP2 = false>
__device__ __forceinline__ void gemm_phase(PG8_LAS unsigned char* lds, const Gemm g, const Sched& S, const Epi& E) {
    int tid_l = threadIdx.x; asm volatile("" : "+v"(tid_l));
    const int tid = tid_l, wid = __builtin_amdgcn_readfirstlane(tid >> 6), lane = tid & 63, wr = wid >> 2, wc = wid & 3, fr = lane & 15, fq = lane >> 4;
    const int K = g.K, nt = K / BK;
    unsigned voffA[2], voffB[2];
#pragma unroll
    for (int i = 0; i < 2; ++i) { int R, C; stage_rc(tid * 16 + i * 8192, R, C); const int Rb = Epi::PERM ? ((R & ~31) + perm32(R & 31)) : R;
        voffA[i] = (unsigned)(R * K + C) * 2u; voffB[i] = (unsigned)(Rb * K + C) * 2u; }
    const size_t kstep = (size_t)(BK * 2);
    const size_t hstep = (size_t)HALF * K * 2;
    const size_t tstep = 2 * hstep;
    const unsigned ldsw = (unsigned)wid * 1024u;
    const int aoff = lds_byte(wr * 64 + fr, fq * 8), boff = lds_byte(wc * 32 + fr, fq * 8);
#define PG8_SA(b, h) (((b) * 2 + (h)) * HTB)
#define PG8_SB(b, h) ((4 + (b) * 2 + (h)) * HTB)
#define PG8_STAGE(bufoff, gbase, voff) do { _Pragma("unroll") for (int _i = 0; _i < 2; ++_i) \
        __builtin_amdgcn_global_load_lds((const unsigned*)((const char*)(gbase) + (voff)[_i]), (PG8_LAS unsigned*)(lds + (bufoff) + ldsw + _i * 8192), 16, 0, 0); } while (0)
#define PG8_LDA(dst, b, h) do { _Pragma("unroll") for (int m = 0; m < 4; ++m) _Pragma("unroll") for (int k = 0; k < 2; ++k) dst[m][k] = *(const PG8_LAS bf16x8*)(lds + PG8_SA(b, h) + aoff + m * 2048 + k * 1024); } while (0)
#define PG8_LDB(dst, b, h) do { _Pragma("unroll") for (int n = 0; n < 2; ++n) _Pragma("unroll") for (int k = 0; k < 2; ++k) dst[n][k] = *(const PG8_LAS bf16x8*)(lds + PG8_SB(b, h) + boff + n * 2048 + k * 1024); } while (0)
#define PG8_MMA(ai, bj, At, Bt) do { __builtin_amdgcn_s_setprio(1); _Pragma("unroll") for (int m = 0; m < 4; ++m) _Pragma("unroll") for (int n = 0; n < 2; ++n) _Pragma("unroll") for (int k = 0; k < 2; ++k) \
        acc[ai][bj][m][n] = __builtin_amdgcn_mfma_f32_16x16x32_bf16(Bt[n][k], At[m][k], acc[ai][bj][m][n], 0, 0, 0); __builtin_amdgcn_s_setprio(0); } while (0)
#define PG8_WAIT_V(n) asm volatile("s_waitcnt vmcnt(" #n ")" ::: "memory")
#define PG8_WAIT_L(n) asm volatile("s_waitcnt lgkmcnt(" #n ")" ::: "memory")
#define PG8_BAR __builtin_amdgcn_s_barrier()
#define PG8_SCHED __builtin_amdgcn_sched_barrier(0)
    Unit cur, nxt; int ui = 0;
    if (!S.next(0, cur)) return;
    f32x4 acc[2][2][4][2];
#pragma unroll
    for (int a = 0; a < 2; ++a)
#pragma unroll
        for (int b = 0; b < 2; ++b)
#pragma unroll
            for (int m = 0; m < 4; ++m)
#pragma unroll
                for (int n = 0; n < 2; ++n) acc[a][b][m][n] = (f32x4){0.f, 0.f, 0.f, 0.f};
    bf16x8 At[4][2], B0[2][2], B1[2][2];
    const char* cA = (const char*)g.A + (size_t)cur.pm * tstep; const char* cB = (const char*)g.Bt + (size_t)cur.pn * tstep;
    S.a_ready(cur);
    if constexpr (SP2) {
        PG8_STAGE(PG8_SB(0, 0), cB, voffB); PG8_STAGE(PG8_SB(0, 1), cB + hstep, voffB); PG8_STAGE(PG8_SA(0, 0), cA, voffA); PG8_STAGE(PG8_SA(0, 1), cA + hstep, voffA);
        if (wr == 1) PG8_BAR;
        PG8_WAIT_V(2); PG8_BAR;
        PG8_STAGE(PG8_SB(1, 0), cB + kstep, voffB); PG8_STAGE(PG8_SA(1, 0), cA + kstep, voffA); PG8_STAGE(PG8_SB(1, 1), cB + hstep + kstep, voffB);
        PG8_WAIT_V(6); PG8_BAR;
    } else {
        PG8_STAGE(PG8_SB(0, 0), cB, voffB); PG8_STAGE(PG8_SA(0, 0), cA, voffA); PG8_STAGE(PG8_SB(0, 1), cB + hstep, voffB); PG8_STAGE(PG8_SA(0, 1), cA + hstep, voffA);
        if (wr == 1) PG8_BAR;
        PG8_WAIT_V(4); PG8_BAR;
        PG8_STAGE(PG8_SB(1, 0), cB + kstep, voffB); PG8_STAGE(PG8_SA(1, 0), cA + kstep, voffA); PG8_STAGE(PG8_SB(1, 1), cB + hstep + kstep, voffB);
        PG8_WAIT_V(6); PG8_BAR;
    }
    for (;;) {
        const bool has_next = S.next(ui + 1, nxt);
        const char* nA = has_next ? (const char*)g.A + (size_t)nxt.pm * tstep : cA; const char* nB = has_next ? (const char*)g.Bt + (size_t)nxt.pn * tstep : cB;
        for (int t = 0; t < nt; t += 2) {
            const bool last = (t == nt - 2);
            const char* a1 = cA + (size_t)(t + 1) * kstep;
            const char* a2 = last ? nA : cA + (size_t)(t + 2) * kstep; const char* b2 = last ? nB : cB + (size_t)(t + 2) * kstep;
            const char* a3 = a2 + kstep; const char* b3 = b2 + kstep;
            if (last && has_next) S.a_ready(nxt);
            if constexpr (SP2) {
            PG8_LDB(B0, 0, 0); PG8_LDB(B1, 0, 1); PG8_SCHED; PG8_LDA(At, 0, 0); PG8_STAGE(PG8_SA(1, 1), a1 + hstep, voffA);
            PG8_WAIT_V(8); PG8_WAIT_L(0); PG8_BAR; PG8_MMA(0, 0, At, B0); PG8_MMA(0, 1, At, B1); PG8_BAR; PG8_SCHED;
            PG8_LDA(At, 0, 1); PG8_STAGE(PG8_SB(0, 0), b2, voffB); PG8_STAGE(PG8_SB(0, 1), b2 + hstep, voffB); PG8_STAGE(PG8_SA(0, 0), a2, voffA);
            PG8_WAIT_V(8); PG8_WAIT_L(0); PG8_BAR; PG8_MMA(1, 0, At, B0); PG8_MMA(1, 1, At, B1); PG8_BAR; PG8_SCHED;
            PG8_LDB(B0, 1, 0); PG8_LDB(B1, 1, 1); PG8_SCHED; PG8_LDA(At, 1, 0); PG8_STAGE(PG8_SA(0, 1), a2 + hstep, voffA);
            PG8_WAIT_V(8); PG8_WAIT_L(0); PG8_BAR; PG8_MMA(0, 0, At, B0); PG8_MMA(0, 1, At, B1); PG8_BAR; PG8_SCHED;
            PG8_LDA(At, 1, 1); PG8_STAGE(PG8_SB(1, 0), b3, voffB); PG8_STAGE(PG8_SB(1, 1), b3 + hstep, voffB); PG8_STAGE(PG8_SA(1, 0), a3, voffA);
            PG8_WAIT_V(8); PG8_WAIT_L(0); PG8_BAR; PG8_MMA(1, 0, At, B0); PG8_MMA(1, 1, At, B1); PG8_BAR; PG8_SCHED;
            } else {
            PG8_LDB(B0, 0, 0); PG8_SCHED; PG8_LDA(At, 0, 0); PG8_STAGE(PG8_SA(1, 1), a1 + hstep, voffA);
            PG8_WAIT_L(8); PG8_BAR; PG8_WAIT_L(0); PG8_MMA(0, 0, At, B0); PG8_BAR; PG8_SCHED;
            PG8_LDB(B1, 0, 1); PG8_STAGE(PG8_SB(0, 0), b2, voffB);
            PG8_BAR; PG8_WAIT_L(0); PG8_MMA(0, 1, At, B1); PG8_BAR;
            PG8_LDA(At, 0, 1); PG8_STAGE(PG8_SA(0, 0), a2, voffA);
            PG8_BAR; PG8_WAIT_L(0); PG8_MMA(1, 0, At, B0); PG8_BAR; PG8_SCHED;
            PG8_STAGE(PG8_SB(0, 1), b2 + hstep, voffB);
            PG8_WAIT_V(6); PG8_BAR; PG8_MMA(1, 1, At, B1); PG8_BAR;
            PG8_LDB(B0, 1, 0); PG8_SCHED; PG8_LDA(At, 1, 0); PG8_STAGE(PG8_SA(0, 1), a2 + hstep, voffA);
            PG8_WAIT_L(8); PG8_BAR; PG8_WAIT_L(0); PG8_MMA(0, 0, At, B0); PG8_BAR; PG8_SCHED;
            PG8_LDB(B1, 1, 1); PG8_STAGE(PG8_SB(1, 0), b3, voffB);
            PG8_BAR; PG8_WAIT_L(0); PG8_MMA(0, 1, At, B1); PG8_BAR;
            PG8_LDA(At, 1, 1); PG8_STAGE(PG8_SA(1, 0), a3, voffA);
            PG8_BAR; PG8_WAIT_L(0); PG8_MMA(1, 0, At, B0); PG8_BAR; PG8_SCHED;
            PG8_STAGE(PG8_SB(1, 1), b3 + hstep, voffB);
            PG8_WAIT_V(6); PG8_BAR; PG8_MMA(1, 1, At, B1); PG8_BAR;
            }
        }
        if constexpr (ALIGN_EPI) { if (wr == 0) PG8_BAR; }
        if constexpr (!Epi::AFTER_DRAIN) { E(acc, cur, wr, wc, fr, fq); S.done(cur); }
        if (!has_next) break;
#pragma unroll
        for (int a = 0; a < 2; ++a)
#pragma unroll
            for (int b = 0; b < 2; ++b)
#pragma unroll
                for (int m = 0; m < 4; ++m)
#pragma unroll
                    for (int n = 0; n < 2; ++n) acc[a][b][m][n] = (f32x4){0.f, 0.f, 0.f, 0.f};
        cur = nxt; cA = nA; cB = nB; ++ui;
        if constexpr (ALIGN_EPI) { if (wr == 1) PG8_BAR; }
    }
    PG8_WAIT_V(0);
    if constexpr (!ALIGN_EPI) { if (wr == 0) PG8_BAR; }
    PG8_BAR;
    if constexpr (Epi::AFTER_DRAIN) { E.fused(acc, cur, wr, wc, fr, fq, lds, wid, lane); S.done(cur); }
#undef PG8_SA
#undef PG8_SB
#undef PG8_STAGE
#undef PG8_LDA
#undef PG8_LDB
#undef PG8_MMA
#undef PG8_WAIT_V
#undef PG8_WAIT_L
#undef PG8_BAR
#undef PG8_SCHED
}
}
constexpr int NTHR = 512;
constexpr int SEQ = 8192, NTOK = 16384, DM = 1024, INC = 4104, PJ = 4096, DMIX = 1536, DFF = 2816, DEPTH = 2;
constexpr int C_Q = 0, C_K = 512, C_V = 1024, C_Z = 1536, C_XBC = 2048, C_GL = 3072, C_XL = 3584;
constexpr float LOG2E = 1.4426950408889634f;
constexpr size_t MiB = 1u << 20;
constexpr size_t WS_DT = 1 * MiB, WS_LSE = WS_DT + 512 * 1024, WS_AGA = 2 * MiB, WS_AGH = WS_AGA + 512 * 1024, WS_CD = 3 * MiB;
constexpr size_t WS_WIN = 4 * MiB, WS_WOUT = 12 * MiB, WS_WGU = 15 * MiB, WS_WD = 26 * MiB;
constexpr size_t WS_XN = 32 * MiB;
constexpr size_t WS_ST = WS_XN, WS_PL = WS_XN + 16 * MiB;
constexpr size_t WS_PROJ = 64 * MiB;
constexpr size_t WS_MIX = 192 * MiB;
constexpr size_t WS_END = 240 * MiB;
constexpr int LDS_BYTES = 153600;

#define LAS __attribute__((address_space(3)))
typedef unsigned short bf16;
typedef float f32x4 __attribute__((ext_vector_type(4)));
typedef float f32x2 __attribute__((ext_vector_type(2)));
typedef short bf16x8 __attribute__((ext_vector_type(8)));
typedef short bf16x4 __attribute__((ext_vector_type(4)));
typedef unsigned u32x4 __attribute__((ext_vector_type(4)));
typedef unsigned u32x2 __attribute__((ext_vector_type(2)));
#define LDS_WAIT() asm volatile("s_waitcnt lgkmcnt(0)" ::: "memory")

__device__ __forceinline__ unsigned f2bf(float f) { unsigned u = __builtin_bit_cast(unsigned, f); return (u + 0x7fffu + ((u >> 16) & 1u)) >> 16; }
__device__ __forceinline__ unsigned pk2(float lo, float hi) { return f2bf(lo) | (f2bf(hi) << 16); }
__device__ __forceinline__ float bf2f(unsigned short b) { return __builtin_bit_cast(float, (unsigned)b << 16); }
__device__ __forceinline__ float bflo(unsigned w) { return __builtin_bit_cast(float, w << 16); }
__device__ __forceinline__ float bfhi(unsigned w) { return __builtin_bit_cast(float, w & 0xffff0000u); }
__device__ __forceinline__ float wave_sum(float v) {
#pragma unroll
    for (int o = 1; o < 64; o <<= 1) v += __shfl_xor(v, o);
    return v;
}
__device__ __forceinline__ float softplusf(float x) { return fmaxf(x, 0.f) + log1pf(__expf(-fabsf(x))); }
__device__ __forceinline__ float sigmoidf_(float x) { return 1.0f / (1.0f + __expf(-x)); }
__device__ __forceinline__ float siluf_(float x) { return x / (1.0f + __expf(-x)); }
__device__ __forceinline__ float gelu_tanh(float x) { const float u = 0.7978845608028654f * (x + 0.044715f * x * x * x); return x * (1.0f / (1.0f + __expf(-2.0f * u))); }
__device__ __forceinline__ f32x4 mfma16(bf16x8 a, bf16x8 b, f32x4 c) { return __builtin_amdgcn_mfma_f32_16x16x32_bf16(a, b, c, 0, 0, 0); }
__device__ __forceinline__ bf16x8 cat8(u32x2 lo, u32x2 hi) { u32x4 w; w.x = lo.x; w.y = lo.y; w.z = hi.x; w.w = hi.y; return __builtin_bit_cast(bf16x8, w); }

struct Params {
    const float* in[22];
    float* out; unsigned char* ws;
};

__device__ __forceinline__ void wt_item(const float* W, int ldw, int col0, int k0, const float* gain, bf16* WT, int K, int drow0, LAS float* scr, int lane) {
#pragma unroll 8
    for (int i = 0; i < 32; ++i) { const int kk = 2 * i + (lane >> 5); float w = W[(size_t)(k0 + kk) * ldw + col0 + (lane & 31)]; if (gain) w *= gain[k0 + kk]; scr[kk * 33 + (lane & 31)] = w; }
    LDS_WAIT(); asm volatile("" ::: "memory");
    const int c = lane & 7;
#pragma unroll
    for (int j = 0; j < 4; ++j) { const int n = (lane >> 3) + 8 * j; const LAS float* s = scr + (8 * c) * 33 + n;
        u32x4 o; o.x = pk2(s[0 * 33], s[1 * 33]); o.y = pk2(s[2 * 33], s[3 * 33]); o.z = pk2(s[4 * 33], s[5 * 33]); o.w = pk2(s[6 * 33], s[7 * 33]);
        *(u32x4*)(WT + (size_t)(drow0 + n) * K + k0 + 8 * c) = o; }
    LDS_WAIT(); asm volatile("" ::: "memory");
}
__device__ __forceinline__ void weights_phase(const Params& p, int l, unsigned char* ws, LAS unsigned char* lds, int gw, int NGW, int wave, int lane) {
    LAS float* scr = (LAS float*)(lds + wave * 16384);
    const float* w_in = p.in[2] + (size_t)l * DM * INC; const float* g1 = p.in[1] + l * DM;
    const float* w_out = p.in[16] + (size_t)l * DMIX * DM;
    const float* g2 = p.in[17] + l * DM; const float* w_gate = p.in[18] + (size_t)l * DM * DFF; const float* w_up = p.in[19] + (size_t)l * DM * DFF;
    const float* w_down = p.in[20] + (size_t)l * DFF * DM;
    bf16* WinT = (bf16*)(ws + WS_WIN); bf16* WoutT = (bf16*)(ws + WS_WOUT); bf16* WguT = (bf16*)(ws + WS_WGU); bf16* WdT = (bf16*)(ws + WS_WD);
    constexpr int I_IN = (DM / 64) * (PJ / 32), I_OUT = (DMIX / 64) * (DM / 32), I_GU = (DM / 64) * (2 * DFF / 32), I_D = (DFF / 64) * (DM / 32);
    for (int it = gw; it < I_IN + I_OUT + I_GU + I_D; it += NGW) {
        int r = it;
        if (r < I_IN) { const int nb = r % (PJ / 32), kb = r / (PJ / 32), n0 = 32 * nb; wt_item(w_in, INC, n0 < 3072 ? n0 : n0 + 8, 64 * kb, g1, WinT, DM, n0, scr, lane); continue; } r -= I_IN;
        if (r < I_OUT) { const int nb = r % (DM / 32), kb = r / (DM / 32); wt_item(w_out, DM, 32 * nb, 64 * kb, nullptr, WoutT, DMIX, 32 * nb, scr, lane); continue; } r -= I_OUT;
        if (r < I_GU) { const int nb = r % (2 * DFF / 32), kb = r / (2 * DFF / 32), n0 = 32 * nb, pn = n0 >> 8, wi = n0 & 255;
            const float* src = wi < 128 ? w_gate : w_up; const int f0 = 128 * pn + (wi & 127); wt_item(src, DFF, f0, 64 * kb, g2, WguT, DM, n0, scr, lane); continue; } r -= I_GU;
        { const int nb = r % (DM / 32), kb = r / (DM / 32); wt_item(w_down, DM, 32 * nb, 64 * kb, nullptr, WdT, DFF, 32 * nb, scr, lane); }
    }
}
__device__ __forceinline__ void norm_dt_phase(const float* xin, bf16* XN, const float* g, const float* w_in, const float* dt_bias, float* DT, int gw, int NGW, int lane) {
    float wd[4][4][8];
#pragma unroll
    for (int j = 0; j < 4; ++j)
#pragma unroll
        for (int e = 0; e < 4; ++e) { const int k = 256 * j + 4 * lane + e; const float gk = g[k]; const f32x4* wp = (const f32x4*)(w_in + (size_t)k * INC + 3072); const f32x4 a = wp[0], b = wp[1];
#pragma unroll
            for (int q = 0; q < 4; ++q) { wd[j][e][q] = a[q] * gk; wd[j][e][4 + q] = b[q] * gk; } }
    const float bias = dt_bias[lane & 7];
    for (int m = gw; m < NTOK; m += NGW) {
        const f32x4* xr = (const f32x4*)(xin + (size_t)m * DM) + lane;
        f32x4 v[4]; float ss = 0.f; float d[8];
#pragma unroll
        for (int q = 0; q < 8; ++q) d[q] = 0.f;
#pragma unroll
        for (int j = 0; j < 4; ++j) { v[j] = xr[64 * j];
#pragma unroll
            for (int e = 0; e < 4; ++e) { ss += v[j][e] * v[j][e];
#pragma unroll
                for (int q = 0; q < 8; ++q) d[q] += v[j][e] * wd[j][e][q]; } }
        ss = wave_sum(ss); const float rs = 1.0f / sqrtf(ss * (1.0f / DM) + 1e-6f);
#pragma unroll
        for (int q = 0; q < 8; ++q) d[q] = wave_sum(d[q]);
        unsigned long long* o8 = (unsigned long long*)(XN + (size_t)m * DM) + lane;
#pragma unroll
        for (int j = 0; j < 4; ++j) o8[64 * j] = (unsigned long long)pk2(v[j][0] * rs, v[j][1] * rs) | ((unsigned long long)pk2(v[j][2] * rs, v[j][3] * rs) << 32);
        float dv = d[0];
#pragma unroll
        for (int q = 1; q < 8; ++q) dv = (lane == q) ? d[q] : dv;
        if (lane < 8) DT[(size_t)m * 8 + lane] = softplusf(dv * rs + bias);
    }
}
__device__ __forceinline__ void norm_phase(const float* xin, bf16* XN, int gw, int NGW, int lane) {
    for (int m = gw; m < NTOK; m += NGW) {
        const f32x4* xr = (const f32x4*)(xin + (size_t)m * DM) + lane;
        f32x4 v[4]; float ss = 0.f;
#pragma unroll
        for (int j = 0; j < 4; ++j) { v[j] = xr[64 * j]; ss += (v[j][0] * v[j][0] + v[j][1] * v[j][1]) + (v[j][2] * v[j][2] + v[j][3] * v[j][3]); }
        ss = wave_sum(ss); const float rs = 1.0f / sqrtf(ss * (1.0f / DM) + 1e-6f);
        unsigned long long* o8 = (unsigned long long*)(XN + (size_t)m * DM) + lane;
#pragma unroll
        for (int j = 0; j < 4; ++j) o8[64 * j] = (unsigned long long)pk2(v[j][0] * rs, v[j][1] * rs) | ((unsigned long long)pk2(v[j][2] * rs, v[j][3] * rs) << 32);
    }
}
__device__ __forceinline__ void final_norm_phase(float* x, const float* g, int gw, int NGW, int lane) {
    f32x4 gv[4];
#pragma unroll
    for (int j = 0; j < 4; ++j) gv[j] = ((const f32x4*)g)[64 * j + lane];
    for (int m = gw; m < NTOK; m += NGW) {
        f32x4* xr = (f32x4*)(x + (size_t)m * DM) + lane;
        f32x4 v[4]; float ss = 0.f;
#pragma unroll
        for (int j = 0; j < 4; ++j) { v[j] = xr[64 * j]; ss += (v[j][0] * v[j][0] + v[j][1] * v[j][1]) + (v[j][2] * v[j][2] + v[j][3] * v[j][3]); }
        ss = wave_sum(ss); const float rs = 1.0f / sqrtf(ss * (1.0f / DM) + 1e-6f);
#pragma unroll
        for (int j = 0; j < 4; ++j) xr[64 * j] = v[j] * rs * gv[j];
    }
}
constexpr int VP = 260;
__device__ __forceinline__ void attn_item(LAS unsigned char* lds, const bf16* PROJ, bf16* MIX, float* LSE, int pat, int it, int tid) {
    asm volatile("" : "+v"(tid)); const int lane = tid & 63, wid = __builtin_amdgcn_readfirstlane(tid >> 6);
    const int fr = lane & 15, fq = lane >> 4;
    const int dil = pat == 0 ? 1 : (pat == 1 ? 4 : 16), nblk = SEQ / dil / 128;
    const int nb = it % nblk, t2 = it / nblk, r = t2 % dil, t3 = t2 / dil, h = t3 & 7, b = t3 >> 3;
    const int j0 = 128 * (nb - 1);
    LAS bf16* Vt = (LAS bf16*)lds;
#pragma unroll
    for (int u = 0; u < 4; ++u) { const int id = tid + NTHR * u, key = id >> 3, dp = id & 7; int jj = j0 + key; jj = jj < 0 ? 0 : jj;
        const size_t row = (size_t)b * SEQ + r + (size_t)dil * jj;
        const bf16x8 vv = *(const bf16x8*)(PROJ + row * PJ + C_V + h * 64 + 8 * dp);
#pragma unroll
        for (int e = 0; e < 8; ++e) Vt[(8 * dp + e) * VP + key] = (bf16)vv[e]; }
    __syncthreads();
    const int qi = 16 * wid + fr; const size_t qrow = (size_t)b * SEQ + r + (size_t)dil * (128 * nb + qi);
    bf16x8 qf[2];
#pragma unroll
    for (int ks = 0; ks < 2; ++ks) qf[ks] = *(const bf16x8*)(PROJ + qrow * PJ + C_Q + h * 64 + 32 * ks + 8 * fq);
    f32x4 s[10];
#pragma unroll
    for (int jt = 0; jt < 10; ++jt) { int kt = wid + jt; kt = kt > 15 ? 15 : kt; int jj = j0 + 16 * kt + fr; jj = jj < 0 ? 0 : jj;
        const size_t krow = (size_t)b * SEQ + r + (size_t)dil * jj; const bf16* kp = PROJ + krow * PJ + C_K + h * 64 + 8 * fq;
        const bf16x8 k0 = *(const bf16x8*)kp, k1 = *(const bf16x8*)(kp + 32);
        f32x4 a = {0.f, 0.f, 0.f, 0.f}; a = mfma16(k0, qf[0], a); a = mfma16(k1, qf[1], a); s[jt] = a; }
    const float sc = 0.125f * LOG2E, sl = exp2f(-(float)(h + 1)) * LOG2E * (float)dil;
    float mx = -1e30f;
#pragma unroll
    for (int jt = 0; jt < 10; ++jt)
#pragma unroll
        for (int v = 0; v < 4; ++v) { const int kk = 16 * jt + 4 * fq + v, dist = 128 + fr - kk, ki = 16 * wid + kk;
            const bool ok = (dist >= 0) && (dist <= 128) && (ki < 256) && (nb > 0 || ki >= 128);
            const float x = ok ? s[jt][v] * sc - sl * (float)dist : -1e30f; s[jt][v] = x; mx = fmaxf(mx, x); }
    mx = fmaxf(mx, __shfl_xor(mx, 16)); mx = fmaxf(mx, __shfl_xor(mx, 32));
    float lsum = 0.f;
#pragma unroll
    for (int jt = 0; jt < 10; ++jt)
#pragma unroll
        for (int v = 0; v < 4; ++v) { const float pv = exp2f(s[jt][v] - mx); s[jt][v] = pv; lsum += pv; }
    lsum += __shfl_xor(lsum, 16); lsum += __shfl_xor(lsum, 32);
    f32x4 o[4];
#pragma unroll
    for (int dt = 0; dt < 4; ++dt) o[dt] = (f32x4){0.f, 0.f, 0.f, 0.f};
#pragma unroll
    for (int u = 0; u < 5; ++u) {
        u32x4 pw; pw.x = pk2(s[2 * u][0], s[2 * u][1]); pw.y = pk2(s[2 * u][2], s[2 * u][3]); pw.z = pk2(s[2 * u + 1][0], s[2 * u + 1][1]); pw.w = pk2(s[2 * u + 1][2], s[2 * u + 1][3]);
        const bf16x8 pb = __builtin_bit_cast(bf16x8, pw);
        int kt0 = wid + 2 * u, kt1 = kt0 + 1; kt0 = kt0 > 15 ? 15 : kt0; kt1 = kt1 > 15 ? 15 : kt1;
#pragma unroll
        for (int dt = 0; dt < 4; ++dt) { const LAS bf16* vr = Vt + (16 * dt + fr) * VP + 4 * fq;
            const u32x2 lo = *(const LAS u32x2*)(vr + 16 * kt0), hi = *(const LAS u32x2*)(vr + 16 * kt1);
            o[dt] = mfma16(cat8(lo, hi), pb, o[dt]); }
    }
    const float inv = 1.0f / lsum; float lse = mx + log2f(lsum);
    bf16* op = MIX + qrow * DMIX + h * 64 + 4 * fq; float* lp = LSE + qrow * 8 + h;
    float c1 = 0.f, c2 = inv;
    if (pat > 0) { const float lpv = *lp; const float M = fmaxf(lpv, lse); const float w1 = exp2f(lpv - M), w2 = exp2f(lse - M), iw = 1.0f / (w1 + w2); c1 = w1 * iw; c2 = w2 * iw * inv; lse = M + log2f(w1 + w2); }
#pragma unroll
    for (int dt = 0; dt < 4; ++dt) { f32x4 ov = o[dt] * c2;
        if (pat > 0) { const u32x2 pr = *(const u32x2*)(op + 16 * dt); ov[0] += c1 * bflo(pr.x); ov[1] += c1 * bfhi(pr.x); ov[2] += c1 * bflo(pr.y); ov[3] += c1 * bfhi(pr.y); }
        u32x2 w; w.x = pk2(ov[0], ov[1]); w.y = pk2(ov[2], ov[3]); *(u32x2*)(op + 16 * dt) = w; }
    if (fq == 0) *lp = lse;
    __syncthreads();
}

constexpr int XP = 136;
constexpr int SSD_XT = 0, SSD_B = 256 * XP * 2, SSD_C = SSD_B + 128 * XP * 2, SSD_TAB = SSD_C + 128 * XP * 2, SSD_END = SSD_TAB + 4096 + 64;
template <int MODE> __device__ __forceinline__ void ssd_conv_channel(const bf16* PROJ, int b, int c, int xcol  , const float* cw, const float* cb, LAS bf16* dst, int drow) {
    const float w0 = cw[xcol], w1 = cw[1024 + xcol], w2 = cw[2048 + xcol], w3 = cw[3072 + xcol], bb = cb[xcol];
    const bf16* src = PROJ + ((size_t)b * SEQ + (size_t)c * 128) * PJ + C_XBC + xcol;
    float xm3 = 0.f, xm2 = 0.f, xm1 = 0.f;
    if (c > 0) { xm3 = bf2f(*(src - 3 * (ptrdiff_t)PJ)); xm2 = bf2f(*(src - 2 * (ptrdiff_t)PJ)); xm1 = bf2f(*(src - (ptrdiff_t)PJ)); }
    for (int tb = 0; tb < 16; ++tb) {
        float xv[8];
#pragma unroll
        for (int e = 0; e < 8; ++e) xv[e] = bf2f(src[(size_t)(8 * tb + e) * PJ]);
#pragma unroll
        for (int e = 0; e < 8; ++e) { const float y = bb + w0 * xm3 + w1 * xm2 + w2 * xm1 + w3 * xv[e]; xm3 = xm2; xm2 = xm1; xm1 = xv[e];
            const bf16 o = (bf16)f2bf(siluf_(y)); const int tok = 8 * tb + e;
            if (MODE == 0) dst[drow * XP + tok] = o; else dst[tok * XP + drow] = o; }
    }
}
__device__ __forceinline__ float ssd_cumsum(const float* DT, const float* a_log, int b, int c, int g, int tid, int wid, int lane, LAS float* tot, float& dtv) {
    const int hh = tid >> 7, i = tid & 127;
    dtv = DT[((size_t)b * SEQ + c * 128 + i) * 8 + 4 * g + hh];
    float v = dtv * (-__expf(a_log[4 * g + hh]));
#pragma unroll
    for (int d = 1; d < 64; d <<= 1) { const float t = __shfl_up(v, d); if (lane >= d) v += t; }
    if (lane == 63) tot[wid] = v;
    __syncthreads();
    if (wid & 1) v += tot[wid - 1];
    return v;
}
__device__ __forceinline__ void ssd_states_item(LAS unsigned char* lds, const Params& p, int l, const bf16* PROJ, const float* DT, bf16* ST, float* CD, int it, int tid) {
    asm volatile("" : "+v"(tid)); const int lane = tid & 63, wid = __builtin_amdgcn_readfirstlane(tid >> 6);
    const int fr = lane & 15, fq = lane >> 4;
    const int g = it & 1, c = (it >> 1) & 63, b = it >> 7;
    LAS bf16* Xt = (LAS bf16*)(lds + SSD_XT); LAS bf16* Bt = (LAS bf16*)(lds + SSD_B);
    LAS float* wts = (LAS float*)(lds + SSD_TAB); LAS float* tot = wts + 1024;
    const float* cw = p.in[3] + (size_t)l * 4 * 1024; const float* cb = p.in[4] + l * 1024;
    if (tid < 256) ssd_conv_channel<0>(PROJ, b, c, 256 * g + tid, cw, cb, Xt, tid);
    else if (tid < 384) ssd_conv_channel<0>(PROJ, b, c, 512 + 128 * g + (tid - 256), cw, cb, Bt, tid - 256);
    float dtv; const float acs = ssd_cumsum(DT, p.in[6] + l * 8, b, c, g, tid, wid, lane, tot, dtv);
    { const int hh = tid >> 7, i = tid & 127; if (i == 127) { tot[8 + hh] = acs; CD[((size_t)b * 64 + c) * 8 + 4 * g + hh] = __expf(acs); } }
    __syncthreads();
    { const int hh = tid >> 7, i = tid & 127; wts[hh * 128 + i] = __expf(tot[8 + hh] - acs) * dtv; }
    __syncthreads();
    const int hh = wid >> 1, nh = wid & 1;
    f32x4 acc[4][4];
#pragma unroll
    for (int pt = 0; pt < 4; ++pt)
#pragma unroll
        for (int nt = 0; nt < 4; ++nt) acc[pt][nt] = (f32x4){0.f, 0.f, 0.f, 0.f};
#pragma unroll
    for (int ks = 0; ks < 4; ++ks) {
        const f32x4 wa = *(const LAS f32x4*)(wts + hh * 128 + 32 * ks + 8 * fq), wb = *(const LAS f32x4*)(wts + hh * 128 + 32 * ks + 8 * fq + 4);
        bf16x8 bfr[4];
#pragma unroll
        for (int nt = 0; nt < 4; ++nt) bfr[nt] = *(const LAS bf16x8*)(Bt + (16 * (4 * nh + nt) + fr) * XP + 32 * ks + 8 * fq);
#pragma unroll
        for (int pt = 0; pt < 4; ++pt) {
            const u32x4 xr = *(const LAS u32x4*)(Xt + (64 * hh + 16 * pt + fr) * XP + 32 * ks + 8 * fq);
            u32x4 xs; xs.x = pk2(bflo(xr.x) * wa[0], bfhi(xr.x) * wa[1]); xs.y = pk2(bflo(xr.y) * wa[2], bfhi(xr.y) * wa[3]);
            xs.z = pk2(bflo(xr.z) * wb[0], bfhi(xr.z) * wb[1]); xs.w = pk2(bflo(xr.w) * wb[2], bfhi(xr.w) * wb[3]);
            const bf16x8 xf = __builtin_bit_cast(bf16x8, xs);
#pragma unroll
            for (int nt = 0; nt < 4; ++nt) acc[pt][nt] = mfma16(bfr[nt], xf, acc[pt][nt]);
        }
    }
    bf16* sp = ST + ((((size_t)b * 64 + c) * 8 + 4 * g + hh) * 64) * 128;
#pragma unroll
    for (int pt = 0; pt < 4; ++pt)
#pragma unroll
        for (int nt = 0; nt < 4; ++nt) { u32x2 w; w.x = pk2(acc[pt][nt][0], acc[pt][nt][1]); w.y = pk2(acc[pt][nt][2], acc[pt][nt][3]);
            *(u32x2*)(sp + (size_t)(16 * pt + fr) * 128 + 16 * (4 * nh + nt) + 4 * fq) = w; }
    __syncthreads();
}
__device__ __forceinline__ void ssd_out_item(LAS unsigned char* lds, const Params& p, int l, const bf16* PROJ, const float* DT, const bf16* ST, bf16* MIX, int it, int tid) {
    asm volatile("" : "+v"(tid)); const int lane = tid & 63, wid = __builtin_amdgcn_readfirstlane(tid >> 6);
    const int fr = lane & 15, fq = lane >> 4;
    const int g = it & 1, c = (it >> 1) & 63, b = it >> 7;
    LAS bf16* Xt = (LAS bf16*)(lds + SSD_XT); LAS bf16* Bm = (LAS bf16*)(lds + SSD_B); LAS bf16* Cm = (LAS bf16*)(lds + SSD_C);
    LAS float* acsT = (LAS float*)(lds + SSD_TAB); LAS float* dtsT = acsT + 512; LAS float* tot = acsT + 1024;
    const float* cw = p.in[3] + (size_t)l * 4 * 1024; const float* cb = p.in[4] + l * 1024;
    if (tid < 256) ssd_conv_channel<0>(PROJ, b, c, 256 * g + tid, cw, cb, Xt, tid);
    else if (tid < 384) ssd_conv_channel<1>(PROJ, b, c, 512 + 128 * g + (tid - 256), cw, cb, Bm, tid - 256);
    else ssd_conv_channel<1>(PROJ, b, c, 768 + 128 * g + (tid - 384), cw, cb, Cm, tid - 384);
    float dtv; const float acs = ssd_cumsum(DT, p.in[6] + l * 8, b, c, g, tid, wid, lane, tot, dtv);
    acsT[tid] = acs; dtsT[tid] = dtv;
    __syncthreads();
    const int w = wid;
    bf16x8 cf[4];
#pragma unroll
    for (int ks = 0; ks < 4; ++ks) cf[ks] = *(const LAS bf16x8*)(Cm + (16 * w + fr) * XP + 32 * ks + 8 * fq);
    const int ii = 16 * w + fr; const size_t row = (size_t)b * SEQ + c * 128 + ii;
    float ssq = 0.f;
    bf16* mrow = MIX + row * DMIX + 512 + 256 * g + 4 * fq;
#pragma unroll 1
    for (int hh = 0; hh < 4; ++hh) {
        const float ai = acsT[hh * 128 + ii];
        f32x4 y[4];
#pragma unroll
        for (int pt = 0; pt < 4; ++pt) y[pt] = (f32x4){0.f, 0.f, 0.f, 0.f};
#pragma unroll
        for (int u = 0; u < 4; ++u) {
            if (2 * u <= w) {
                float sv[8];
                f32x4 gt[2];
#pragma unroll
                for (int q = 0; q < 2; ++q) { gt[q] = (f32x4){0.f, 0.f, 0.f, 0.f};
                    if (2 * u + q <= w) {
#pragma unroll
                        for (int ks = 0; ks < 4; ++ks) gt[q] = mfma16(*(const LAS bf16x8*)(Bm + (16 * (2 * u + q) + fr) * XP + 32 * ks + 8 * fq), cf[ks], gt[q]); } }
#pragma unroll
                for (int q = 0; q < 2; ++q) { const int jt = 2 * u + q; const f32x4 aj = *(const LAS f32x4*)(acsT + hh * 128 + 16 * jt + 4 * fq), dj = *(const LAS f32x4*)(dtsT + hh * 128 + 16 * jt + 4 * fq);
#pragma unroll
                    for (int v = 0; v < 4; ++v) { const int j = 16 * jt + 4 * fq + v; sv[4 * q + v] = (j <= ii) ? gt[q][v] * __expf(fminf(ai - aj[v], 0.f)) * dj[v] : 0.f; } }
                u32x4 pw; pw.x = pk2(sv[0], sv[1]); pw.y = pk2(sv[2], sv[3]); pw.z = pk2(sv[4], sv[5]); pw.w = pk2(sv[6], sv[7]);
                const bf16x8 pb = __builtin_bit_cast(bf16x8, pw);
#pragma unroll
                for (int pt = 0; pt < 4; ++pt) { const LAS bf16* xr = Xt + (64 * hh + 16 * pt + fr) * XP + 32 * u + 4 * fq;
                    y[pt] = mfma16(cat8(*(const LAS u32x2*)xr, *(const LAS u32x2*)(xr + 16)), pb, y[pt]); }
            }
            asm volatile("" ::: "memory");
        }
        const bf16* pp = ST + ((((size_t)b * 64 + c) * 8 + 4 * g + hh) * 64) * 128;
        const float ea = __expf(ai); const float dsk = p.in[7][l * 8 + 4 * g + hh];
#pragma unroll
        for (int pt = 0; pt < 4; ++pt) { f32x4 yo = {0.f, 0.f, 0.f, 0.f};
#pragma unroll
            for (int ks = 0; ks < 4; ++ks) yo = mfma16(*(const bf16x8*)(pp + (size_t)(16 * pt + fr) * 128 + 32 * ks + 8 * fq), cf[ks], yo);
            const int ch = 64 * hh + 16 * pt + 4 * fq;
            const u32x2 zr = *(const u32x2*)(PROJ + row * PJ + C_Z + 256 * g + ch);
            const float zv[4] = {bflo(zr.x), bfhi(zr.x), bflo(zr.y), bfhi(zr.y)};
#pragma unroll
            for (int v = 0; v < 4; ++v) { const float xv = bf2f(Xt[(ch + v) * XP + ii]); const float t = (y[pt][v] + ea * yo[v] + dsk * xv) * siluf_(zv[v]); y[pt][v] = t; ssq += t * t; }
            { u32x2 wv; wv.x = pk2(y[pt][0], y[pt][1]); wv.y = pk2(y[pt][2], y[pt][3]); *(u32x2*)(mrow + 64 * hh + 16 * pt) = wv; }
            asm volatile("" ::: "memory"); }
    }
    ssq += __shfl_xor(ssq, 16); ssq += __shfl_xor(ssq, 32);
    const float rstd = 1.0f / sqrtf(ssq * (1.0f / 256.0f) + 1e-5f);
    const float* nw = p.in[8] + l * 512 + 256 * g;
#pragma unroll 4
    for (int q = 0; q < 16; ++q) { const int ch = 16 * q + 4 * fq; const f32x4 nv = *(const f32x4*)(nw + ch); const u32x2 yr = *(const u32x2*)(mrow + 16 * q);
        const f32x4 yv = {bflo(yr.x), bfhi(yr.x), bflo(yr.y), bfhi(yr.y)}; const f32x4 o = yv * rstd * nv;
        u32x2 wv; wv.x = pk2(o[0], o[1]); wv.y = pk2(o[2], o[3]); *(u32x2*)(mrow + 16 * q) = wv; }
    __syncthreads();
}
static_assert(SSD_END <= LDS_BYTES, "SSD LDS map");
__device__ __forceinline__ void lru_local_item(LAS unsigned char* lds, const Params& p, int l, const bf16* PROJ, bf16* MIX, bf16* PL, float* AGA, float* AGH, int it, int tid) {
    asm volatile("" : "+v"(tid));
    const int kc = it & 127, b = it >> 7, ch = tid, blk = ch >> 6, cc = ch & 63;
    LAS float* xcs = (LAS float*)lds;
    float wa[64], wx[64];
    const float* wap = p.in[11] + (size_t)l * 8 * 64 * 64 + (size_t)blk * 4096 + cc; const float* wxp = p.in[13] + (size_t)l * 8 * 64 * 64 + (size_t)blk * 4096 + cc;
#pragma unroll
    for (int k0 = 0; k0 < 64; k0 += 8) { asm volatile("" : "+v"(wap), "+v"(wxp));
#pragma unroll
        for (int k = 0; k < 8; ++k) { wa[k0 + k] = wap[k * 64]; wx[k0 + k] = wxp[k * 64]; }
        wap += 8 * 64; wxp += 8 * 64; }
    const float* cwp = p.in[9] + (size_t)l * 4 * 512 + ch; const float w0 = cwp[0], w1 = cwp[512], w2 = cwp[1024], w3 = cwp[1536], cb = p.in[10][l * 512 + ch];
    const float ba = p.in[12][l * 512 + ch], bx = p.in[14][l * 512 + ch], sp8 = -8.0f * softplusf(-p.in[15][l * 512 + ch]);
    const size_t row0 = (size_t)b * SEQ + (size_t)kc * 64;
    const bf16* src = PROJ + row0 * PJ + C_XL + ch;
    float xm3 = 0.f, xm2 = 0.f, xm1 = 0.f;
    if (kc > 0) { xm3 = bf2f(*(src - 3 * (ptrdiff_t)PJ)); xm2 = bf2f(*(src - 2 * (ptrdiff_t)PJ)); xm1 = bf2f(*(src - (ptrdiff_t)PJ)); }
    float h = 0.f, P = 1.f;
#pragma unroll 1
    for (int sb = 0; sb < 4; ++sb) {
        float xv[16];
#pragma unroll
        for (int e = 0; e < 16; ++e) xv[e] = bf2f(src[(size_t)(16 * sb + e) * PJ]);
#pragma unroll
        for (int e = 0; e < 16; ++e) { const float y = cb + w0 * xm3 + w1 * xm2 + w2 * xm1 + w3 * xv[e]; xm3 = xm2; xm2 = xm1; xm1 = xv[e]; xcs[e * 512 + ch] = y; }
        __syncthreads();
#pragma unroll 1
        for (int t = 0; t < 16; ++t) {
            float ar = ba, ai = bx;
            const LAS f32x4* xb = (const LAS f32x4*)(xcs + t * 512 + blk * 64);
#pragma unroll
            for (int k4 = 0; k4 < 16; ++k4) { const f32x4 x4 = xb[k4];
#pragma unroll
                for (int e = 0; e < 4; ++e) { ar += x4[e] * wa[4 * k4 + e]; ai += x4[e] * wx[4 * k4 + e]; }
                if ((k4 & 3) == 3) asm volatile("" ::: "memory"); }
            const float xc = xcs[t * 512 + ch];
            const float rg = sigmoidf_(ar), ig = sigmoidf_(ai), la = sp8 * rg, a = __expf(la), u = sqrtf(-expm1f(2.0f * la)) * (ig * xc);
            h = a * h + u; P *= a;
            const size_t row = row0 + 16 * sb + t;
            MIX[row * DMIX + 1024 + ch] = (bf16)f2bf(h); PL[row * 512 + ch] = (bf16)f2bf(P);
        }
        __syncthreads();
    }
    AGA[((size_t)b * 128 + kc) * 512 + ch] = P; AGH[((size_t)b * 128 + kc) * 512 + ch] = h;
}
__device__ __forceinline__ void lru_final_item(const bf16* PROJ, bf16* MIX, const bf16* PL, const float* AGH, int it, int tid) {
    asm volatile("" : "+v"(tid));
    const int kc = it & 127, b = it >> 7, ch = tid;
    const float carry = AGH[((size_t)b * 128 + kc) * 512 + ch];
    const size_t row0 = (size_t)b * SEQ + (size_t)kc * 64;
    for (int tb = 0; tb < 8; ++tb) {
        float hl[8], pv[8], gv[8];
#pragma unroll
        for (int e = 0; e < 8; ++e) { const size_t row = row0 + 8 * tb + e; hl[e] = bf2f(MIX[row * DMIX + 1024 + ch]); pv[e] = bf2f(PL[row * 512 + ch]); gv[e] = bf2f(PROJ[row * PJ + C_GL + ch]); }
#pragma unroll
        for (int e = 0; e < 8; ++e) { const size_t row = row0 + 8 * tb + e; MIX[row * DMIX + 1024 + ch] = (bf16)f2bf((hl[e] + pv[e] * carry) * gelu_tanh(gv[e])); }
    }
}
__device__ __forceinline__ void scans_phase(bf16* ST, const float* CD, const float* AGA, float* AGH, int gtid, int gthreads) {
    for (int e = gtid; e < 2 * 8 * 64 * 128; e += gthreads) {
        const int b = e >> 16, rem = e & 65535, h = rem >> 13;
        bf16* sp = ST + (size_t)b * 64 * 65536 + rem; const float* cd = CD + (size_t)b * 64 * 8 + h;
        float carry = 0.f;
        for (int c0 = 0; c0 < 64; c0 += 16) {
            float s[16], d[16];
#pragma unroll
            for (int q = 0; q < 16; ++q) { s[q] = bf2f(sp[(size_t)(c0 + q) * 65536]); d[q] = cd[(c0 + q) * 8]; }
#pragma unroll
            for (int q = 0; q < 16; ++q) { sp[(size_t)(c0 + q) * 65536] = (bf16)f2bf(carry); carry = d[q] * carry + s[q]; }
        }
    }
    for (int e = gtid; e < 2 * 512; e += gthreads) {
        const int b = e >> 9, ch = e & 511;
        const float* ap = AGA + (size_t)b * 128 * 512 + ch; float* hp = AGH + (size_t)b * 128 * 512 + ch;
        float carry = 0.f;
        for (int c0 = 0; c0 < 128; c0 += 16) {
            float a[16], hh[16];
#pragma unroll
            for (int q = 0; q < 16; ++q) { a[q] = ap[(size_t)(c0 + q) * 512]; hh[q] = hp[(size_t)(c0 + q) * 512]; }
#pragma unroll
            for (int q = 0; q < 16; ++q) { hp[(size_t)(c0 + q) * 512] = carry; carry = a[q] * carry + hh[q]; }
        }
    }
}
__global__ void __launch_bounds__(NTHR, 2) hybrid_fwd(Params p) {
    extern __shared__ __attribute__((aligned(16))) unsigned char lds_raw[];
    LAS unsigned char* lds = (LAS unsigned char*)lds_raw;
    cg::grid_group grid = cg::this_grid();
    const int G = gridDim.x, bid = blockIdx.x, NGW = G * 8;
#define FRESH_TID() int tid = threadIdx.x; asm volatile("" : "+v"(tid)); const int lane = tid & 63, wave = __builtin_amdgcn_readfirstlane(tid >> 6), gw = bid * 8 + wave; (void)lane; (void)gw;
    unsigned char* ws = p.ws;
    float* DT = (float*)(ws + WS_DT); float* LSE = (float*)(ws + WS_LSE); float* AGA = (float*)(ws + WS_AGA); float* AGH = (float*)(ws + WS_AGH); float* CD = (float*)(ws + WS_CD);
    bf16* WinT = (bf16*)(ws + WS_WIN); bf16* WoutT = (bf16*)(ws + WS_WOUT); bf16* WguT = (bf16*)(ws + WS_WGU); bf16* WdT = (bf16*)(ws + WS_WD);
    bf16* XN = (bf16*)(ws + WS_XN); bf16* ST = (bf16*)(ws + WS_ST); bf16* PL = (bf16*)(ws + WS_PL);
    bf16* PROJ = (bf16*)(ws + WS_PROJ); bf16* ACT = (bf16*)(ws + WS_PROJ); bf16* MIX = (bf16*)(ws + WS_MIX);
#pragma unroll 1
    for (int l = 0; l < DEPTH; ++l) {
        const float* xin = (l == 0) ? p.in[0] : p.out;
        { FRESH_TID();
        weights_phase(p, l, ws, lds, gw, NGW, wave, lane);
#ifndef NO_NDT
        norm_dt_phase(xin, XN, p.in[1] + l * DM, p.in[2] + (size_t)l * DM * INC, p.in[5] + l * 8, DT, gw, NGW, lane);
#endif
        }
        grid.sync();
        { pg8::Gemm g{XN, WinT, NTOK, PJ, DM}; pg8::StaticOrder S; S.init(NTOK, PJ, G, bid); pg8::EpiBf16<0> E{PROJ, PJ, nullptr, 0, 0, 1.f};

#if !defined(NO_GEMM) && !defined(NO_G1)
pg8::gemm_phase<pg8::EpiBf16<0>, pg8::StaticOrder, true, true>(lds, g, S, E);
#endif
 }
        grid.sync();
        { FRESH_TID();
        for (int it = bid; it < 512 + 1024; it += G) {
            if (it < 256) {
#ifndef NO_LRU
 lru_local_item(lds, p, l, PROJ, MIX, PL, AGA, AGH, it, tid);
#endif
 }
            else if (it < 512) {
#ifndef NO_SST
 ssd_states_item(lds, p, l, PROJ, DT, ST, CD, it - 256, tid);
#endif
 }
            else {
#ifndef NO_ATT
 attn_item(lds, PROJ, MIX, LSE, 0, it - 512, tid);
#endif
 }
        }
        }
        grid.sync();
        { FRESH_TID();
        scans_phase(ST, CD, AGA, AGH, bid * NTHR + tid, G * NTHR);
        for (int it = bid; it < 1024; it += G) {
#ifndef NO_ATT
 attn_item(lds, PROJ, MIX, LSE, 1, it, tid);
#endif
 }
        }
        grid.sync();
        { FRESH_TID();
        for (int it = bid; it < 512 + 1024; it += G) {
            if (it < 256) {
#ifndef NO_SOUT
 ssd_out_item(lds, p, l, PROJ, DT, ST, MIX, it, tid);
#endif
 }
            else if (it < 512) lru_final_item(PROJ, MIX, PL, AGH, it - 256, tid);
            else {
#ifndef NO_ATT
 attn_item(lds, PROJ, MIX, LSE, 2, it - 512, tid);
#endif
 }
        }
        }
        grid.sync();
        { pg8::Gemm g{MIX, WoutT, NTOK, DM, DMIX}; pg8::StaticOrder S; S.init(NTOK, DM, G, bid); pg8::EpiResF32 E{xin, p.out, DM};

#if !defined(NO_GEMM) && !defined(NO_G2)
pg8::gemm_phase<pg8::EpiResF32, pg8::StaticOrder, true, true>(lds, g, S, E);
#endif
 }
        grid.sync();
        { FRESH_TID(); norm_phase(p.out, XN, gw, NGW, lane); }
        grid.sync();
        { pg8::Gemm g{XN, WguT, NTOK, 2 * DFF, DM}; pg8::StaticOrder S; S.init(NTOK, 2 * DFF, G, bid); pg8::EpiSwiGLU E{ACT, DFF};

#if !defined(NO_GEMM) && !defined(NO_G3)
pg8::gemm_phase<pg8::EpiSwiGLU, pg8::StaticOrder, true, true>(lds, g, S, E);
#endif
 }
        grid.sync();
        { pg8::Gemm g{ACT, WdT, NTOK, DM, DFF}; pg8::StaticOrder S; S.init(NTOK, DM, G, bid); pg8::EpiResF32 E{p.out, p.out, DM};

#if !defined(NO_GEMM) && !defined(NO_G4)
pg8::gemm_phase<pg8::EpiResF32, pg8::StaticOrder, true, true>(lds, g, S, E);
#endif
 }
        grid.sync();
    }
    { FRESH_TID(); final_norm_phase(p.out, p.in[21], gw, NGW, lane); }
}

extern "C" void kernel_launch(void* const* d_in, const int* in_sizes, int n_in, void* d_out, int out_size, void* d_ws, size_t ws_size, hipStream_t stream) {
    static int grid = 0;
    if (grid == 0) {
        if (n_in != 22 || out_size != NTOK * DM || ws_size < WS_END) { fprintf(stderr, "kernel_launch: unexpected shapes (n_in %d out %d ws %zu)\n", n_in, out_size, ws_size); grid = -1; return; }
        int dev = 0, cus = 0, per_cu = 0;
        hipGetDevice(&dev); hipDeviceGetAttribute(&cus, hipDeviceAttributeMultiprocessorCount, dev);
        if (hipFuncSetAttribute((const void*)hybrid_fwd, hipFuncAttributeMaxDynamicSharedMemorySize, LDS_BYTES) != hipSuccess) { fprintf(stderr, "kernel_launch: hipFuncSetAttribute failed\n"); grid = -1; return; }
        if (hipOccupancyMaxActiveBlocksPerMultiprocessor(&per_cu, (const void*)hybrid_fwd, NTHR, LDS_BYTES) != hipSuccess || per_cu < 1) { fprintf(stderr, "kernel_launch: occupancy query failed (%d)\n", per_cu); grid = -1; return; }
        grid = cus * per_cu;
    }
    if (grid < 0) return;
    Params p{};
    for (int i = 0; i < 22; ++i) p.in[i] = (const float*)d_in[i];
    p.out = (float*)d_out; p.ws = (unsigned char*)d_ws;
    void* args[] = {&p};
    hipError_t e = hipLaunchCooperativeKernel((const void*)hybrid_fwd, dim3(grid), dim3(NTHR), args, LDS_BYTES, stream);
    if (e != hipSuccess) fprintf(stderr, "cooperative launch failed: %s (grid %d)\n", hipGetErrorString(e), grid);
}
```

```cpp
#include <hip/hip_runtime.h>
#include <hip/hip_cooperative_groups.h>
#include <cstdio>
#include <cstdint>
namespace cg = cooperative_groups;
namespace pg8 {
#define PG8_LAS __attribute__((address_space(3)))
typedef unsigned short bf16_t;
typedef short bf16x8 __attribute__((ext_vector_type(8)));
typedef float f32x4 __attribute__((ext_vector_type(4)));
typedef unsigned u32x4 __attribute__((ext_vector_type(4)));
constexpr int BM = 256, BK = 64, HALF = 128, HTB = HALF * BK * 2  , STAGE_BYTES = 8 * HTB, NXCD = 8, WGM = 8;

__host__ __device__ __forceinline__ int lds_byte(int r, int c) { const int st = (r >> 4) * 2 + (c >> 5), rr = r & 15, cc = c & 31, ob = rr * 64 + cc * 2; return st * 1024 + (ob ^ (((ob >> 9) & 1) << 5)); }
__host__ __device__ __forceinline__ void stage_rc(int b, int& R, int& C) { const int st = b / 1024, sb = b % 1024, swz = sb ^ (((sb >> 9) & 1) << 5); R = (st >> 1) * 16 + swz / 64; C = (st & 1) * 32 + (swz % 64) / 2; }
__host__ __device__ __forceinline__ int perm32(int rho) { const int n = rho >> 4, i = rho & 15; return 8 * (i >> 2) + 4 * n + (i & 3); }

struct Unit { int pm, pn; };
struct Gemm { const bf16_t* A; const bf16_t* Bt; int M, N, K; };

struct StaticOrder {
    int nM, nN, nwg, G, c;
    __host__ __device__ void init(int M, int N, int G_, int c_) { nM = M / BM; nN = N / BM; nwg = nM * nN; G = G_; c = c_; }
    __host__ __device__ bool next(int i, Unit& u) const {
        const long L = (long)i * G + c; if (L >= nwg) return false;
        int wgid = (int)L; { const int q = nwg / NXCD, r = nwg % NXCD, xcd = wgid % NXCD, off = wgid / NXCD; wgid = (xcd < r ? xcd * (q + 1) : r * (q + 1) + (xcd - r) * q) + off; }
        const int nig = WGM * nN, gid = wgid / nig, fm = gid * WGM, gsz = (nM - fm) < WGM ? (nM - fm) : WGM;
        u.pm = fm + ((wgid % nig) % gsz); u.pn = (wgid % nig) / gsz; return true;
    }
    __device__ __forceinline__ void a_ready(const Unit&) const {}
    __device__ __forceinline__ void done(const Unit&) const {}
};

__device__ __forceinline__ unsigned cvt_pk_bf16(float lo, float hi) { unsigned r; asm volatile("v_cvt_pk_bf16_f32 %0, %1, %2" : "=v"(r) : "v"(lo), "v"(hi)); return r; }
typedef float f32x2 __attribute__((ext_vector_type(2)));
__device__ __forceinline__ f32x2 gelu_pk(f32x2 v) {
    const f32x2 av = __builtin_elementwise_abs(v), d = av * 0.2316418882f + 1.0f;
    f32x2 t; t.x = __builtin_amdgcn_rcpf(d.x); t.y = __builtin_amdgcn_rcpf(d.y);
    f32x2 q = t * 0.5307027145f + (-0.7265760135f); q = q * t + 0.7107068705f; q = q * t + (-0.142248368f); q = q * t + 0.127414796f; q = q * t;
    const f32x2 s = (v * v) * (-0.72134752044f);
    f32x2 e; e.x = __builtin_amdgcn_exp2f(s.x); e.y = __builtin_amdgcn_exp2f(s.y);
    const f32x2 m = v * (q * e), r = v - m;
    f32x2 o; o.x = v.x < 0.f ? m.x : r.x; o.y = v.y < 0.f ? m.y : r.y; return o;
}

template <int ACT  > struct EpiBf16 {
    static constexpr bool PERM = true, AFTER_DRAIN = false; static_assert(ACT == 0 || ACT == 1, "EpiBf16: ACT is 0 (none) or 1 (gelu_pk)");
    bf16_t* O; int ldc; const float* bias; int split_cols; size_t split_stride; float scale0;
    __device__ __forceinline__ void operator()(const f32x4 (&acc)[2][2][4][2], const Unit& u, int wr, int wc, int fr, int fq) const {
        const int row0 = u.pm * BM + wr * 64 + fr; int colt = u.pn * BM; bf16_t* base = O;
        float sc = 1.f; if (split_cols) { const int t = colt / split_cols; base += (size_t)t * split_stride; colt -= t * split_cols; if (t == 0) sc = scale0; }
        const int col0 = colt + wc * 32 + 8 * fq, bcol0 = u.pn * BM + wc * 32 + 8 * fq;
        f32x4 bv[2][2];
#pragma unroll
        for (int bj = 0; bj < 2; ++bj)
#pragma unroll
            for (int n = 0; n < 2; ++n) bv[bj][n] = bias ? *(const f32x4*)(bias + bcol0 + bj * HALF + 4 * n) : (f32x4){0.f, 0.f, 0.f, 0.f};
#pragma unroll
        for (int ai = 0; ai < 2; ++ai)
#pragma unroll
            for (int m = 0; m < 4; ++m) { bf16_t* rowp = base + (size_t)(row0 + ai * HALF + m * 16) * ldc + col0;
#pragma unroll
                for (int bj = 0; bj < 2; ++bj) { f32x4 v0 = acc[ai][bj][m][0] + bv[bj][0], v1 = acc[ai][bj][m][1] + bv[bj][1];
                    if (ACT == 1) { f32x2 a = gelu_pk((f32x2){v0[0], v0[1]}), b = gelu_pk((f32x2){v0[2], v0[3]}), c = gelu_pk((f32x2){v1[0], v1[1]}), d = gelu_pk((f32x2){v1[2], v1[3]});
                        v0 = (f32x4){a.x, a.y, b.x, b.y}; v1 = (f32x4){c.x, c.y, d.x, d.y}; }
                    v0 = v0 * sc; v1 = v1 * sc; u32x4 w; w.x = cvt_pk_bf16(v0[0], v0[1]); w.y = cvt_pk_bf16(v0[2], v0[3]); w.z = cvt_pk_bf16(v1[0], v1[1]); w.w = cvt_pk_bf16(v1[2], v1[3]);
                    *(u32x4*)(rowp + bj * HALF) = w; } }
    }
};
struct EpiResF32 {
    static constexpr bool PERM = false, AFTER_DRAIN = false;
    const float* base; float* out; int ldc;
    __device__ __forceinline__ void operator()(const f32x4 (&acc)[2][2][4][2], const Unit& u, int wr, int wc, int fr, int fq) const {
        const int row0 = u.pm * BM + wr * 64 + fr, col0 = u.pn * BM + wc * 32 + 4 * fq;
#pragma unroll
        for (int ai = 0; ai < 2; ++ai)
#pragma unroll
            for (int m = 0; m < 4; ++m) { const size_t off = (size_t)(row0 + ai * HALF + m * 16) * ldc + col0;
#pragma unroll
                for (int bj = 0; bj < 2; ++bj)
#pragma unroll
                    for (int n = 0; n < 2; ++n) { const f32x4 b = *(const f32x4*)(base + off + bj * HALF + n * 16); *(f32x4*)(out + off + bj * HALF + n * 16) = b + acc[ai][bj][m][n]; } }
    }
};
template <bool BASE_F32> struct EpiResBf {
    static constexpr bool PERM = true, AFTER_DRAIN = false;
    const void* base; bf16_t* out; int ldc; float* rsp;
    __device__ __forceinline__ void operator()(const f32x4 (&acc)[2][2][4][2], const Unit& u, int wr, int wc, int fr, int fq) const {
        const int row0 = u.pm * BM + wr * 64 + fr, col0 = u.pn * BM + wc * 32 + 8 * fq;
#pragma unroll
        for (int ai = 0; ai < 2; ++ai)
#pragma unroll
            for (int m = 0; m < 4; ++m) { const size_t off = (size_t)(row0 + ai * HALF + m * 16) * ldc + col0; float ss = 0.f;
#pragma unroll
                for (int bj = 0; bj < 2; ++bj) { f32x4 b0, b1;
                    if (BASE_F32) { const float* bp = (const float*)base + off + bj * HALF; b0 = *(const f32x4*)bp; b1 = *(const f32x4*)(bp + 4); }
                    else { const u32x4 w = *(const u32x4*)((const bf16_t*)base + off + bj * HALF);
                        b0 = (f32x4){__builtin_bit_cast(float, w.x << 16), __builtin_bit_cast(float, w.x & 0xffff0000u), __builtin_bit_cast(float, w.y << 16), __builtin_bit_cast(float, w.y & 0xffff0000u)};
                        b1 = (f32x4){__builtin_bit_cast(float, w.z << 16), __builtin_bit_cast(float, w.z & 0xffff0000u), __builtin_bit_cast(float, w.w << 16), __builtin_bit_cast(float, w.w & 0xffff0000u)}; }
                    const f32x4 v0 = b0 + acc[ai][bj][m][0], v1 = b1 + acc[ai][bj][m][1];
                    u32x4 o; o.x = cvt_pk_bf16(v0[0], v0[1]); o.y = cvt_pk_bf16(v0[2], v0[3]); o.z = cvt_pk_bf16(v1[0], v1[1]); o.w = cvt_pk_bf16(v1[2], v1[3]);
                    *(u32x4*)(out + off + bj * HALF) = o;
                    ss += ((v0[0] * v0[0] + v0[1] * v0[1]) + (v0[2] * v0[2] + v0[3] * v0[3])) + ((v1[0] * v1[0] + v1[1] * v1[1]) + (v1[2] * v1[2] + v1[3] * v1[3])); }
                if (rsp) { ss += __shfl_xor(ss, 16); ss += __shfl_xor(ss, 32); if (fq == 0) rsp[(size_t)(row0 + ai * HALF + m * 16) * 16 + 4 * u.pn + wc] = ss; } }
    }
};
struct EpiSwiGLU {
    static constexpr bool PERM = true, AFTER_DRAIN = false;
    bf16_t* O; int ldc; const float* rsp;
    __device__ __forceinline__ void operator()(const f32x4 (&acc)[2][2][4][2], const Unit& u, int wr, int wc, int fr, int fq) const {
        const int row0 = u.pm * BM + wr * 64 + fr, f0 = u.pn * 128 + wc * 32 + 8 * fq;
#pragma unroll
        for (int ai = 0; ai < 2; ++ai)
#pragma unroll
            for (int m = 0; m < 4; ++m) { bf16_t* rowp = O + (size_t)(row0 + ai * HALF + m * 16) * ldc + f0;
                const f32x4* rp = (const f32x4*)(rsp + (size_t)(row0 + ai * HALF + m * 16) * 16); const f32x4 q0 = rp[0], q1 = rp[1], q2 = rp[2], q3 = rp[3];
                const float tot = ((q0[0] + q0[1]) + (q0[2] + q0[3])) + ((q1[0] + q1[1]) + (q1[2] + q1[3])) + ((q2[0] + q2[1]) + (q2[2] + q2[3])) + ((q3[0] + q3[1]) + (q3[2] + q3[3]));
                const float rs = __builtin_amdgcn_rsqf(tot * (1.0f / 1024.0f) + 1e-6f);
                float r[8];
#pragma unroll
                for (int n = 0; n < 2; ++n)
#pragma unroll
                    for (int e = 0; e < 4; ++e) { const float g = acc[ai][0][m][n][e] * rs, up = acc[ai][1][m][n][e] * rs; r[4 * n + e] = g * up * __builtin_amdgcn_rcpf(1.0f + __builtin_amdgcn_exp2f(-1.4426950408889634f * g)); }
                u32x4 w; w.x = cvt_pk_bf16(r[0], r[1]); w.y = cvt_pk_bf16(r[2], r[3]); w.z = cvt_pk_bf16(r[4], r[5]); w.w = cvt_pk_bf16(r[6], r[7]);
                *(u32x4*)rowp = w; }
    }
};
template <class Epi, class Sched, bool ALIGN_EPI = false, bool SP2 = false>
__device__ __forceinline__ void gemm_phase(PG8_LAS unsigned char* lds, const Gemm g, const Sched& S, const Epi& E) {
    int tid_l = threadIdx.x; asm volatile("" : "+v"(tid_l));
    const int tid = tid_l, wid = __builtin_amdgcn_readfirstlane(tid >> 6), lane = tid & 63, wr = wid >> 2, wc = wid & 3, fr = lane & 15, fq = lane >> 4;
    const int K = g.K, nt = K / BK;
    unsigned voffA[2], voffB[2];
#pragma unroll
    for (int i = 0; i < 2; ++i) { int R, C; stage_rc(tid * 16 + i * 8192, R, C); const int Rb = Epi::PERM ? ((R & ~31) + perm32(R & 31)) : R;
        voffA[i] = (unsigned)(R * K + C) * 2u; voffB[i] = (unsigned)(Rb * K + C) * 2u; }
    const size_t kstep = (size_t)(BK * 2);
    const size_t hstep = (size_t)HALF * K * 2;
    const size_t tstep = 2 * hstep;
    const unsigned ldsw = (unsigned)wid * 1024u;
    const int aoff = lds_byte(wr * 64 + fr, fq * 8), boff = lds_byte(wc * 32 + fr, fq * 8);
#define PG8_SA(b, h) (((b) * 2 + (h)) * HTB)
#define PG8_SB(b, h) ((4 + (b) * 2 + (h)) * HTB)
#define PG8_STAGE(bufoff, gbase, voff) do { _Pragma("unroll") for (int _i = 0; _i < 2; ++_i) \
        __builtin_amdgcn_global_load_lds((const unsigned*)((const char*)(gbase) + (voff)[_i]), (PG8_LAS unsigned*)(lds + (bufoff) + ldsw + _i * 8192), 16, 0, 0); } while (0)
#define PG8_LDA(dst, b, h) do { _Pragma("unroll") for (int m = 0; m < 4; ++m) _Pragma("unroll") for (int k = 0; k < 2; ++k) dst[m][k] = *(const PG8_LAS bf16x8*)(lds + PG8_SA(b, h) + aoff + m * 2048 + k * 1024); } while (0)
#define PG8_LDB(dst, b, h) do { _Pragma("unroll") for (int n = 0; n < 2; ++n) _Pragma("unroll") for (int k = 0; k < 2; ++k) dst[n][k] = *(const PG8_LAS bf16x8*)(lds + PG8_SB(b, h) + boff + n * 2048 + k * 1024); } while (0)
#define PG8_MMA(ai, bj, At, Bt) do { __builtin_amdgcn_s_setprio(1); _Pragma("unroll") for (int m = 0; m < 4; ++m) _Pragma("unroll") for (int n = 0; n < 2; ++n) _Pragma("unroll") for (int k = 0; k < 2; ++k) \
        acc[ai][bj][m][n] = __builtin_amdgcn_mfma_f32_16x16x32_bf16(Bt[n][k], At[m][k], acc[ai][bj][m][n], 0, 0, 0); __builtin_amdgcn_s_setprio(0); } while (0)
#define PG8_WAIT_V(n) asm volatile("s_waitcnt vmcnt(" #n ")" ::: "memory")
#define PG8_WAIT_L(n) asm volatile("s_waitcnt lgkmcnt(" #n ")" ::: "memory")
#define PG8_BAR __builtin_amdgcn_s_barrier()
#define PG8_SCHED __builtin_amdgcn_sched_barrier(0)
    Unit cur, nxt; int ui = 0;
    if (!S.next(0, cur)) return;
    f32x4 acc[2][2][4][2];
#pragma unroll
    for (int a = 0; a < 2; ++a)
#pragma unroll
        for (int b = 0; b < 2; ++b)
#pragma unroll
            for (int m = 0; m < 4; ++m)
#pragma unroll
                for (int n = 0; n < 2; ++n) acc[a][b][m][n] = (f32x4){0.f, 0.f, 0.f, 0.f};
    bf16x8 At[4][2], B0[2][2], B1[2][2];
    const char* cA = (const char*)g.A + (size_t)cur.pm * tstep; const char* cB = (const char*)g.Bt + (size_t)cur.pn * tstep;
    S.a_ready(cur);
    if constexpr (SP2) {
        PG8_STAGE(PG8_SB(0, 0), cB, voffB); PG8_STAGE(PG8_SB(0, 1), cB + hstep, voffB); PG8_STAGE(PG8_SA(0, 0), cA, voffA); PG8_STAGE(PG8_SA(0, 1), cA + hstep, voffA);
        if (wr == 1) PG8_BAR;
        PG8_WAIT_V(2); PG8_BAR;
        PG8_STAGE(PG8_SB(1, 0), cB + kstep, voffB); PG8_STAGE(PG8_SA(1, 0), cA + kstep, voffA); PG8_STAGE(PG8_SB(1, 1), cB + hstep + kstep, voffB);
        PG8_WAIT_V(6); PG8_BAR;
    } else {
        PG8_STAGE(PG8_SB(0, 0), cB, voffB); PG8_STAGE(PG8_SA(0, 0), cA, voffA); PG8_STAGE(PG8_SB(0, 1), cB + hstep, voffB); PG8_STAGE(PG8_SA(0, 1), cA + hstep, voffA);
        if (wr == 1) PG8_BAR;
        PG8_WAIT_V(4); PG8_BAR;
        PG8_STAGE(PG8_SB(1, 0), cB + kstep, voffB); PG8_STAGE(PG8_SA(1, 0), cA + kstep, voffA); PG8_STAGE(PG8_SB(1, 1), cB + hstep + kstep, voffB);
        PG8_WAIT_V(6); PG8_BAR;
    }
    for (;;) {
        const bool has_next = S.next(ui + 1, nxt);
        const char* nA = has_next ? (const char*)g.A + (size_t)nxt.pm * tstep : cA; const char* nB = has_next ? (const char*)g.Bt + (size_t)nxt.pn * tstep : cB;
        for (int t = 0; t < nt; t += 2) {
            const bool last = (t == nt - 2);
            const char* a1 = cA + (size_t)(t + 1) * kstep;
            const char* a2 = last ? nA : cA + (size_t)(t + 2) * kstep; const char* b2 = last ? nB : cB + (size_t)(t + 2) * kstep;
            const char* a3 = a2 + kstep; const char* b3 = b2 + kstep;
            if (last && has_next) S.a_ready(nxt);
            if constexpr (SP2) {
            PG8_LDB(B0, 0, 0); PG8_LDB(B1, 0, 1); PG8_SCHED; PG8_LDA(At, 0, 0); PG8_STAGE(PG8_SA(1, 1), a1 + hstep, voffA);
            PG8_WAIT_V(8); PG8_WAIT_L(0); PG8_BAR; PG8_MMA(0, 0, At, B0); PG8_MMA(0, 1, At, B1); PG8_BAR; PG8_SCHED;
            PG8_LDA(At, 0, 1); PG8_STAGE(PG8_SB(0, 0), b2, voffB); PG8_STAGE(PG8_SB(0, 1), b2 + hstep, voffB); PG8_STAGE(PG8_SA(0, 0), a2, voffA);
            PG8_WAIT_V(8); PG8_WAIT_L(0); PG8_BAR; PG8_MMA(1, 0, At, B0); PG8_MMA(1, 1, At, B1); PG8_BAR; PG8_SCHED;
            PG8_LDB(B0, 1, 0); PG8_LDB(B1, 1, 1); PG8_SCHED; PG8_LDA(At, 1, 0); PG8_STAGE(PG8_SA(0, 1), a2 + hstep, voffA);
            PG8_WAIT_V(8); PG8_WAIT_L(0); PG8_BAR; PG8_MMA(0, 0, At, B0); PG8_MMA(0, 1, At, B1); PG8_BAR; PG8_SCHED;
            PG8_LDA(At, 1, 1); PG8_STAGE(PG8_SB(1, 0), b3, voffB); PG8_STAGE(PG8_SB(1, 1), b3 + hstep, voffB); PG8_STAGE(PG8_SA(1, 0), a3, voffA);
            PG8_WAIT_V(8); PG8_WAIT_L(0); PG8_BAR; PG8_MMA(1, 0, At, B0); PG8_MMA(1, 1, At, B1); PG8_BAR; PG8_SCHED;
            } else {
            PG8_LDB(B0, 0, 0); PG8_SCHED; PG8_LDA(At, 0, 0); PG8_STAGE(PG8_SA(1, 1), a1 + hstep, voffA);
            PG8_WAIT_L(8); PG8_BAR; PG8_WAIT_L(0); PG8_MMA(0, 0, At, B0); PG8_BAR; PG8_SCHED;
            PG8_LDB(B1, 0, 1); PG8_STAGE(PG8_SB(0, 0), b2, voffB);
            PG8_BAR; PG8_WAIT_L(0); PG8_MMA(0, 1, At, B1); PG8_BAR;
            PG8_LDA(At, 0, 1); PG8_STAGE(PG8_SA(0, 0), a2, voffA);
            PG8_BAR; PG8_WAIT_L(0); PG8_MMA(1, 0, At, B0); PG8_BAR; PG8_SCHED;
            PG8_STAGE(PG8_SB(0, 1), b2 + hstep, voffB);
            PG8_WAIT_V(6); PG8_BAR; PG8_MMA(1, 1, At, B1); PG8_BAR;
            PG8_LDB(B0, 1, 0); PG8_SCHED; PG8_LDA(At, 1, 0); PG8_STAGE(PG8_SA(0, 1), a2 + hstep, voffA);
            PG8_WAIT_L(8); PG8_BAR; PG8_WAIT_L(0); PG8_MMA(0, 0, At, B0); PG8_BAR; PG8_SCHED;
            PG8_LDB(B1, 1, 1); PG8_STAGE(PG8_SB(1, 0), b3, voffB);
            PG8_BAR; PG8_WAIT_L(0); PG8_MMA(0, 1, At, B1); PG8_BAR;
            PG8_LDA(At, 1, 1); PG8_STAGE(PG8_SA(1, 0), a3, voffA);
            PG8_BAR; PG8_WAIT_L(0); PG8_MMA(1, 0, At, B0); PG8_BAR; PG8_SCHED;
            PG8_STAGE(PG8_SB(1, 1), b3 + hstep, voffB);
            PG8_WAIT_V(6); PG8_BAR; PG8_MMA(1, 1, At, B1); PG8_BAR;
            }
        }
        if constexpr (ALIGN_EPI) { if (wr == 0) PG8_BAR; }
        if constexpr (!Epi::AFTER_DRAIN) { E(acc, cur, wr, wc, fr, fq); S.done(cur); }
        if (!has_next) break;
#pragma unroll
        for (int a = 0; a < 2; ++a)
#pragma unroll
            for (int b = 0; b < 2; ++b)
#pragma unroll
                for (int m = 0; m < 4; ++m)
#pragma unroll
                    for (int n = 0; n < 2; ++n) acc[a][b][m][n] = (f32x4){0.f, 0.f, 0.f, 0.f};
        cur = nxt; cA = nA; cB = nB; ++ui;
        if constexpr (ALIGN_EPI) { if (wr == 1) PG8_BAR; }
    }
    PG8_WAIT_V(0);
    if constexpr (!ALIGN_EPI) { if (wr == 0) PG8_BAR; }
    PG8_BAR;
    if constexpr (Epi::AFTER_DRAIN) { E.fused(acc, cur, wr, wc, fr, fq, lds, wid, lane); S.done(cur); }
#undef PG8_SA
#undef PG8_SB
#undef PG8_STAGE
#undef PG8_LDA
#undef PG8_LDB
#undef PG8_MMA
#undef PG8_WAIT_V
#undef PG8_WAIT_L
#undef PG8_BAR
#undef PG8_SCHED
}
}
constexpr int NTHR = 512;
constexpr int SEQ = 8192, NTOK = 16384, DM = 1024, INC = 4104, PJ = 4096, DMIX = 1536, DFF = 2816, DEPTH = 2;
constexpr int C_Q = 0, C_K = 512, C_V = 1024, C_Z = 1536, C_XBC = 2048, C_GL = 3072, C_XL = 3584;
constexpr float LOG2E = 1.4426950408889634f;
constexpr size_t MiB = 1u << 20;
constexpr size_t WS_DT = 1 * MiB, WS_LSE = WS_DT + 512 * 1024, WS_AGA = 2 * MiB, WS_AGH = WS_AGA + 512 * 1024, WS_CD = 64 * 1024, WS_RSP = 3 * MiB;
constexpr size_t WS_WIN = 4 * MiB, WS_WOUT = 12 * MiB, WS_WGU = 15 * MiB, WS_WD = 26 * MiB;
constexpr size_t WS_XN = 32 * MiB;
constexpr size_t WS_ST = WS_XN, WS_PL = WS_XN + 16 * MiB;
constexpr size_t WS_PROJ = 64 * MiB;
constexpr size_t WS_MIX = 192 * MiB;
constexpr size_t WS_WOUT1 = 240 * MiB, WS_WGU1 = 243 * MiB;
constexpr size_t WS_END = 254 * MiB;
constexpr int LDS_BYTES = 153600;

#define LAS __attribute__((address_space(3)))
typedef unsigned short bf16;
typedef float f32x4 __attribute__((ext_vector_type(4)));
typedef float f32x2 __attribute__((ext_vector_type(2)));
typedef short bf16x8 __attribute__((ext_vector_type(8)));
typedef short bf16x4 __attribute__((ext_vector_type(4)));
typedef unsigned u32x4 __attribute__((ext_vector_type(4)));
typedef unsigned u32x2 __attribute__((ext_vector_type(2)));
#define LDS_WAIT() asm volatile("s_waitcnt lgkmcnt(0)" ::: "memory")

typedef __bf16 hbf16x2 __attribute__((ext_vector_type(2)));
__device__ __forceinline__ unsigned pk2(float lo, float hi) { const f32x2 v = {lo, hi}; const hbf16x2 b = __builtin_convertvector(v, hbf16x2); return __builtin_bit_cast(unsigned, b); }
__device__ __forceinline__ unsigned f2bf(float f) { return pk2(f, 0.f) & 0xffffu; }
__device__ __forceinline__ float bf2f(unsigned short b) { return __builtin_bit_cast(float, (unsigned)b << 16); }
__device__ __forceinline__ float bflo(unsigned w) { return __builtin_bit_cast(float, w << 16); }
__device__ __forceinline__ float bfhi(unsigned w) { return __builtin_bit_cast(float, w & 0xffff0000u); }
__device__ __forceinline__ float wave_sum(float v) {
#pragma unroll
    for (int o = 1; o < 64; o <<= 1) v += __shfl_xor(v, o);
    return v;
}
__device__ __forceinline__ float softplusf(float x) { return fmaxf(x, 0.f) + log1pf(__expf(-fabsf(x))); }
__device__ __forceinline__ float fexp(float x) { return __builtin_amdgcn_exp2f(x * LOG2E); }
__device__ __forceinline__ float sigmoidf_(float x) { return __builtin_amdgcn_rcpf(1.0f + fexp(-x)); }
__device__ __forceinline__ float siluf_(float x) { return x * __builtin_amdgcn_rcpf(1.0f + fexp(-x)); }
__device__ __forceinline__ float gelu_tanh(float x) { const float u = 0.7978845608028654f * (x + 0.044715f * x * x * x); return x * __builtin_amdgcn_rcpf(1.0f + fexp(-2.0f * u)); }
__device__ __forceinline__ f32x4 mfma16(bf16x8 a, bf16x8 b, f32x4 c) { return __builtin_amdgcn_mfma_f32_16x16x32_bf16(a, b, c, 0, 0, 0); }
__device__ __forceinline__ bf16x8 cat8(u32x2 lo, u32x2 hi) { u32x4 w; w.x = lo.x; w.y = lo.y; w.z = hi.x; w.w = hi.y; return __builtin_bit_cast(bf16x8, w); }

struct Params {
    const float* in[22];
    float* out; unsigned char* ws;
};

struct WtItem { const float* src; const float* gain; bf16* dst; int ldw, K; };
struct WtDst { bf16 *in, *out, *gu, *d; };
__device__ __forceinline__ WtItem wt_decode(const Params& p, int l, const WtDst& D, int it) {
    const float* w_in = p.in[2] + (size_t)l * DM * INC; const float* g1 = p.in[1] + l * DM;
    const float* w_out = p.in[16] + (size_t)l * DMIX * DM;
    const float* g2 = p.in[17] + l * DM; const float* w_gate = p.in[18] + (size_t)l * DM * DFF; const float* w_up = p.in[19] + (size_t)l * DM * DFF;
    const float* w_down = p.in[20] + (size_t)l * DFF * DM;
    bf16* WinT = D.in; bf16* WoutT = D.out; bf16* WguT = D.gu; bf16* WdT = D.d;
    constexpr int I_IN = (DM / 64) * (PJ / 32), I_OUT = (DMIX / 64) * (DM / 32), I_GU = (DM / 64) * (2 * DFF / 32);
    WtItem w; int r = it;
    if (r < I_IN) { const int nb = r % (PJ / 32), kb = r / (PJ / 32), n0 = 32 * nb, k0 = 64 * kb; w.src = w_in + (size_t)k0 * INC + (n0 < 3072 ? n0 : n0 + 8); w.gain = g1 + k0; w.dst = WinT + (size_t)n0 * DM + k0; w.ldw = INC; w.K = DM; return w; } r -= I_IN;
    if (r < I_OUT) { const int nb = r % (DM / 32), kb = r / (DM / 32), k0 = 64 * kb; w.src = w_out + (size_t)k0 * DM + 32 * nb; w.gain = nullptr; w.dst = WoutT + (size_t)(32 * nb) * DMIX + k0; w.ldw = DM; w.K = DMIX; return w; } r -= I_OUT;
    if (r < I_GU) { const int nb = r % (2 * DFF / 32), kb = r / (2 * DFF / 32), n0 = 32 * nb, pn = n0 >> 8, wi = n0 & 255, k0 = 64 * kb;
        w.src = (wi < 128 ? w_gate : w_up) + (size_t)k0 * DFF + 128 * pn + (wi & 127); w.gain = g2 + k0; w.dst = WguT + (size_t)n0 * DM + k0; w.ldw = DFF; w.K = DM; return w; } r -= I_GU;
    { const int nb = r % (DM / 32), kb = r / (DM / 32), k0 = 64 * kb; w.src = w_down + (size_t)k0 * DM + 32 * nb; w.gain = nullptr; w.dst = WdT + (size_t)(32 * nb) * DFF + k0; w.ldw = DM; w.K = DFF; return w; }
}
constexpr int WT_EARLY = (DM / 64) * (PJ / 32) + (DMIX / 64) * (DM / 32) + (DM / 64) * (2 * DFF / 32), WT_ALL = WT_EARLY + (DFF / 64) * (DM / 32);
__device__ __forceinline__ void weights_phase(const Params& p, int l, const WtDst& D, int lo, int NITEMS, LAS unsigned char* lds, int gw, int NGW, int wave, int lane) {
    LAS float* scr = (LAS float*)(lds + wave * 16384);
    if (lo + gw >= NITEMS) return;
    WtItem nx = wt_decode(p, l, D, lo + gw);
    float wn[32];
#pragma unroll
    for (int i = 0; i < 32; ++i) wn[i] = nx.src[(size_t)(2 * i + (lane >> 5)) * nx.ldw + (lane & 31)];
#pragma unroll 1
    for (int it = lo + gw; it < NITEMS; it += NGW) {
        const WtItem cu = nx; float wv[32];
#pragma unroll
        for (int i = 0; i < 32; ++i) wv[i] = wn[i];
        if (it + NGW < NITEMS) { nx = wt_decode(p, l, D, it + NGW);
#pragma unroll
            for (int i = 0; i < 32; ++i) wn[i] = nx.src[(size_t)(2 * i + (lane >> 5)) * nx.ldw + (lane & 31)]; }
        if (cu.gain) {
#pragma unroll
            for (int i = 0; i < 32; ++i) wv[i] *= cu.gain[2 * i + (lane >> 5)]; }
#pragma unroll
        for (int i = 0; i < 32; ++i) scr[(2 * i + (lane >> 5)) * 33 + (lane & 31)] = wv[i];
        LDS_WAIT(); asm volatile("" ::: "memory");
        const int c = lane & 7;
#pragma unroll
        for (int j = 0; j < 4; ++j) { const int n = (lane >> 3) + 8 * j; const LAS float* s = scr + (8 * c) * 33 + n;
            u32x4 o; o.x = pk2(s[0 * 33], s[1 * 33]); o.y = pk2(s[2 * 33], s[3 * 33]); o.z = pk2(s[4 * 33], s[5 * 33]); o.w = pk2(s[6 * 33], s[7 * 33]);
            *(u32x4*)(cu.dst + (size_t)n * cu.K + 8 * c) = o; }
        LDS_WAIT(); asm volatile("" ::: "memory");
    }
}
template <bool IN_BF16> __device__ __forceinline__ void load_row(const void* x, size_t m, int lane, f32x4 (&v)[4]) {
    if (IN_BF16) { const u32x2* xr = (const u32x2*)((const bf16*)x + m * DM) + lane;
#pragma unroll
        for (int j = 0; j < 4; ++j) { const u32x2 w = xr[64 * j]; v[j] = (f32x4){bflo(w.x), bfhi(w.x), bflo(w.y), bfhi(w.y)}; } }
    else { const f32x4* xr = (const f32x4*)((const float*)x + m * DM) + lane;
#pragma unroll
        for (int j = 0; j < 4; ++j) v[j] = xr[64 * j]; }
}
template <bool IN_BF16> __device__ __forceinline__ void norm_dt_phase(const void* xin, bf16* XN, const float* g, const float* w_in, const float* dt_bias, float* DT, int gw, int NGW, int lane, LAS unsigned char* lds, int tid) {
    LAS float* wtab = (LAS float*)lds;
    __syncthreads();
    for (int k = tid; k < DM; k += NTHR) { const float gk = g[k]; const f32x4* wp = (const f32x4*)(w_in + (size_t)k * INC + 3072); *(LAS f32x4*)(wtab + 8 * k) = wp[0] * gk; *(LAS f32x4*)(wtab + 8 * k + 4) = wp[1] * gk; }
    __syncthreads();
    float wd[4][4][8];
#pragma unroll
    for (int j = 0; j < 4; ++j)
#pragma unroll
        for (int e = 0; e < 4; ++e) { const int k = 256 * j + 4 * lane + e; const f32x4 a = *(const LAS f32x4*)(wtab + 8 * k), b = *(const LAS f32x4*)(wtab + 8 * k + 4);
#pragma unroll
            for (int q = 0; q < 4; ++q) { wd[j][e][q] = a[q]; wd[j][e][4 + q] = b[q]; } }
    const float bias = dt_bias[lane & 7];
    f32x4 vn[4];
    if (gw < NTOK) load_row<IN_BF16>(xin, (size_t)gw, lane, vn);
#pragma unroll 1
    for (int m = gw; m < NTOK; m += NGW) {
        f32x4 v[4]; float ss = 0.f; float d[8];
#pragma unroll
        for (int j = 0; j < 4; ++j) v[j] = vn[j];
        if (m + NGW < NTOK) load_row<IN_BF16>(xin, (size_t)(m + NGW), lane, vn);
#pragma unroll
        for (int q = 0; q < 8; ++q) d[q] = 0.f;
#pragma unroll
        for (int j = 0; j < 4; ++j) {
#pragma unroll
            for (int e = 0; e < 4; ++e) { ss += v[j][e] * v[j][e];
#pragma unroll
                for (int q = 0; q < 8; ++q) d[q] += v[j][e] * wd[j][e][q]; } }
        ss = wave_sum(ss); const float rs = 1.0f / sqrtf(ss * (1.0f / DM) + 1e-6f);
#pragma unroll
        for (int q = 0; q < 8; ++q) d[q] = wave_sum(d[q]);
        unsigned long long* o8 = (unsigned long long*)(XN + (size_t)m * DM) + lane;
#pragma unroll
        for (int j = 0; j < 4; ++j) o8[64 * j] = (unsigned long long)pk2(v[j][0] * rs, v[j][1] * rs) | ((unsigned long long)pk2(v[j][2] * rs, v[j][3] * rs) << 32);
        float dv = d[0];
#pragma unroll
        for (int q = 1; q < 8; ++q) dv = (lane == q) ? d[q] : dv;
        if (lane < 8) DT[(size_t)m * 8 + lane] = softplusf(dv * rs + bias);
    }
}
__device__ __forceinline__ void norm_phase(const bf16* xin, bf16* XN, int gw, int NGW, int lane) {
    f32x4 vn[4];
    if (gw < NTOK) load_row<true>(xin, (size_t)gw, lane, vn);
#pragma unroll 1
    for (int m = gw; m < NTOK; m += NGW) {
        f32x4 v[4]; float ss = 0.f;
#pragma unroll
        for (int j = 0; j < 4; ++j) v[j] = vn[j];
        if (m + NGW < NTOK) load_row<true>(xin, (size_t)(m + NGW), lane, vn);
#pragma unroll
        for (int j = 0; j < 4; ++j) ss += (v[j][0] * v[j][0] + v[j][1] * v[j][1]) + (v[j][2] * v[j][2] + v[j][3] * v[j][3]);
        ss = wave_sum(ss); const float rs = 1.0f / sqrtf(ss * (1.0f / DM) + 1e-6f);
        unsigned long long* o8 = (unsigned long long*)(XN + (size_t)m * DM) + lane;
#pragma unroll
        for (int j = 0; j < 4; ++j) o8[64 * j] = (unsigned long long)pk2(v[j][0] * rs, v[j][1] * rs) | ((unsigned long long)pk2(v[j][2] * rs, v[j][3] * rs) << 32);
    }
}
__device__ __forceinline__ void final_norm_phase(const bf16* xin, float* out, const float* g, int gw, int NGW, int lane) {
    f32x4 gv[4];
#pragma unroll
    for (int j = 0; j < 4; ++j) gv[j] = ((const f32x4*)g)[64 * j + lane];
    f32x4 vn[4];
    if (gw < NTOK) load_row<true>(xin, (size_t)gw, lane, vn);
#pragma unroll 1
    for (int m = gw; m < NTOK; m += NGW) {
        f32x4 v[4]; float ss = 0.f;
#pragma unroll
        for (int j = 0; j < 4; ++j) v[j] = vn[j];
        if (m + NGW < NTOK) load_row<true>(xin, (size_t)(m + NGW), lane, vn);
#pragma unroll
        for (int j = 0; j < 4; ++j) ss += (v[j][0] * v[j][0] + v[j][1] * v[j][1]) + (v[j][2] * v[j][2] + v[j][3] * v[j][3]);
        ss = wave_sum(ss); const float rs = 1.0f / sqrtf(ss * (1.0f / DM) + 1e-6f);
        f32x4* xr = (f32x4*)(out + (size_t)m * DM) + lane;
#pragma unroll
        for (int j = 0; j < 4; ++j) xr[64 * j] = v[j] * rs * gv[j];
    }
}
constexpr int KP = 72, ATT_KB = 256 * KP * 2, ATT_VB = ATT_KB, ATT_K0 = 0, ATT_V0 = 2 * ATT_KB;
typedef short v4i16_t __attribute__((ext_vector_type(4)));
__device__ __forceinline__ u32x2 lds_tr16(const LAS bf16* p) { return __builtin_bit_cast(u32x2, __builtin_amdgcn_ds_read_tr16_b64_v4i16((LAS v4i16_t*)p)); }
static_assert(ATT_V0 + 2 * ATT_VB <= LDS_BYTES - 1024, "attention LDS map");
#define ATT_DECODE(it_, b_, h_, r_, nb_) const int nb_ = (it_) % nblk, t2_##b_ = (it_) / nblk, r_ = t2_##b_ % dil, t3_##b_ = t2_##b_ / dil, h_ = t3_##b_ & 7, b_ = t3_##b_ >> 3
#define ATT_ISSUE(it_) do { ATT_DECODE(it_, bI, hI, rI, nbI); const int j0I = 128 * (nbI - 1); \
    _Pragma("unroll") for (int u = 0; u < 4; ++u) { const int id = tid + NTHR * u, key = id >> 3, dp = id & 7; int jj = j0I + key; jj = jj < 0 ? 0 : jj; \
        const bf16* rp = PROJ + ((size_t)bI * SEQ + rI + (size_t)dil * jj) * PJ + hI * 64 + 8 * dp; kreg[u] = *(const bf16x8*)(rp + C_K); vreg[u] = *(const bf16x8*)(rp + C_V); } \
    { const size_t qrowI = (size_t)bI * SEQ + rI + (size_t)dil * (128 * nbI + 16 * wid + fr); \
      _Pragma("unroll") for (int ks = 0; ks < 2; ++ks) qn[ks] = *(const bf16x8*)(PROJ + qrowI * PJ + C_Q + hI * 64 + 32 * ks + 8 * fq); } } while (0)
#define ATT_WRITE(buf_) do { LAS bf16* KBw = (LAS bf16*)(lds + ATT_K0 + (buf_) * ATT_KB); LAS bf16* VTw = (LAS bf16*)(lds + ATT_V0 + (buf_) * ATT_VB); \
    _Pragma("unroll") for (int u = 0; u < 4; ++u) { const int id = tid + NTHR * u, key = id >> 3, dp = id & 7; *(LAS bf16x8*)(KBw + key * KP + 8 * dp) = kreg[u]; *(LAS bf16x8*)(VTw + key * KP + 8 * dp) = vreg[u]; } } while (0)
__device__ __forceinline__ void attn_phase(LAS unsigned char* lds, const bf16* PROJ, bf16* MIX, float* LSE, int pat, int first  , int G, int tid) {
    asm volatile("" : "+v"(tid)); const int lane = tid & 63, wid = __builtin_amdgcn_readfirstlane(tid >> 6);
    const int fr = lane & 15, fq = lane >> 4;
    const int dil = pat == 0 ? 1 : (pat == 1 ? 4 : 16), nblk = SEQ / dil / 128;
    int it = (int)(((long)first * 1024) / G); const int it_end = (int)(((long)(first + 1) * 1024) / G); if (it >= it_end) return;
    bf16x8 kreg[4], vreg[4], qn[2], qf[2];
    ATT_ISSUE(it); ATT_WRITE(0); qf[0] = qn[0]; qf[1] = qn[1];
    __syncthreads();
#pragma unroll 1
    for (int n = 0;; ++n) {
        const int itn = it + 1; const bool has_next = itn < it_end;
        if (has_next) ATT_ISSUE(itn);
        ATT_DECODE(it, b, h, r, nb);
        const LAS bf16* KB = (const LAS bf16*)(lds + ATT_K0 + (n & 1) * ATT_KB); const LAS bf16* Vt = (const LAS bf16*)(lds + ATT_V0 + (n & 1) * ATT_VB);
        const int qi = 16 * wid + fr; const size_t qrow = (size_t)b * SEQ + r + (size_t)dil * (128 * nb + qi);
        bf16* op = MIX + qrow * DMIX + h * 64 + 4 * fq; float* lp = LSE + qrow * 8 + h;
        u32x2 pr[4]; float lpv = 0.f;
        if (pat > 0) { lpv = *lp;
#pragma unroll
            for (int dt = 0; dt < 4; ++dt) pr[dt] = *(const u32x2*)(op + 16 * dt); }
        const float sc = 0.125f * LOG2E, sl = exp2f(-(float)(h + 1)) * LOG2E * (float)dil, cl = -sl * (float)(128 + fr - 4 * fq);
        f32x4 s[10]; float mx = -1e30f; unsigned tvm = 0u;
#pragma unroll
        for (int jt = 0; jt < 9; ++jt) {
            const bool tv = (wid + jt <= 15) && (nb > 0 || wid + jt >= 8);
            if (tv) { tvm |= 1u << jt; const LAS bf16* kp = KB + (16 * (wid + jt) + fr) * KP + 8 * fq;
                f32x4 a = {0.f, 0.f, 0.f, 0.f}; a = mfma16(*(const LAS bf16x8*)kp, qf[0], a); a = mfma16(*(const LAS bf16x8*)(kp + 32), qf[1], a);
#pragma unroll
                for (int v = 0; v < 4; ++v) { float x = a[v] * sc + (cl + sl * (float)(16 * jt + v));
                    if (jt == 0) x = (4 * fq + v >= fr) ? x : -1e30f;
                    if (jt == 8) x = (4 * fq + v <= fr) ? x : -1e30f;
                    a[v] = x; mx = fmaxf(mx, x); }
                s[jt] = a; }
            else s[jt] = (f32x4){-1e30f, -1e30f, -1e30f, -1e30f};
        }
        mx = fmaxf(mx, __shfl_xor(mx, 16)); mx = fmaxf(mx, __shfl_xor(mx, 32));
        float lsum = 0.f;
#pragma unroll
        for (int jt = 0; jt < 9; ++jt) {
            if ((tvm >> jt) & 1u) {
#pragma unroll
                for (int v = 0; v < 4; ++v) { const float pv = __builtin_amdgcn_exp2f(s[jt][v] - mx); s[jt][v] = pv; lsum += pv; } }
            else s[jt] = (f32x4){0.f, 0.f, 0.f, 0.f};
        }
        s[9] = (f32x4){0.f, 0.f, 0.f, 0.f};
        lsum += __shfl_xor(lsum, 16); lsum += __shfl_xor(lsum, 32);
        f32x4 o[4];
#pragma unroll
        for (int dt = 0; dt < 4; ++dt) o[dt] = (f32x4){0.f, 0.f, 0.f, 0.f};
#pragma unroll
        for (int u = 0; u < 5; ++u) {
            u32x4 pw; pw.x = pk2(s[2 * u][0], s[2 * u][1]); pw.y = pk2(s[2 * u][2], s[2 * u][3]); pw.z = pk2(s[2 * u + 1][0], s[2 * u + 1][1]); pw.w = pk2(s[2 * u + 1][2], s[2 * u + 1][3]);
            const bf16x8 pb = __builtin_bit_cast(bf16x8, pw);
            int kt0 = wid + 2 * u, kt1 = kt0 + 1; kt0 = kt0 > 15 ? 15 : kt0; kt1 = kt1 > 15 ? 15 : kt1;
#pragma unroll
            for (int dt = 0; dt < 4; ++dt) { const LAS bf16* vr = Vt + (4 * fq + (fr >> 2)) * KP + 16 * dt + 4 * (fr & 3);
                const u32x2 lo = lds_tr16(vr + 16 * kt0 * KP), hi = lds_tr16(vr + 16 * kt1 * KP);
                o[dt] = mfma16(cat8(lo, hi), pb, o[dt]); }
        }
        const float inv = __builtin_amdgcn_rcpf(lsum); float lse = mx + __builtin_amdgcn_logf(lsum);
        float c1 = 0.f, c2 = inv;
        if (pat > 0) { const float M = fmaxf(lpv, lse); const float w1 = __builtin_amdgcn_exp2f(lpv - M), w2 = __builtin_amdgcn_exp2f(lse - M), iw = __builtin_amdgcn_rcpf(w1 + w2); c1 = w1 * iw; c2 = w2 * iw * inv; lse = M + __builtin_amdgcn_logf(w1 + w2); }
#pragma unroll
        for (int dt = 0; dt < 4; ++dt) { f32x4 ov = o[dt] * c2;
            if (pat > 0) { ov[0] += c1 * bflo(pr[dt].x); ov[1] += c1 * bfhi(pr[dt].x); ov[2] += c1 * bflo(pr[dt].y); ov[3] += c1 * bfhi(pr[dt].y); }
            u32x2 w; w.x = pk2(ov[0], ov[1]); w.y = pk2(ov[2], ov[3]); *(u32x2*)(op + 16 * dt) = w; }
        if (fq == 0) *lp = lse;
        if (has_next) { ATT_WRITE((n + 1) & 1); qf[0] = qn[0]; qf[1] = qn[1]; }
        __syncthreads();
        if (!has_next) break;
        it = itn;
    }
}

constexpr int XP = 136, XR = 272;
constexpr int SSD_XT = 0, SSD_B = 256 * XP * 2, SSD_C = SSD_B + 128 * XP * 2, SSD_TAB = SSD_C + 128 * XP * 2, SSD_END = SSD_TAB + 4096 + 64 + 512;
template <int PITCH> __device__ __forceinline__ void ssd_conv_pair(const bf16* PROJ, int b, int c, int th, int xcol, const float* cw, const float* cb, LAS bf16* dst, int dcol) {
    const f32x2 w0 = *(const f32x2*)(cw + xcol), w1 = *(const f32x2*)(cw + 1024 + xcol), w2 = *(const f32x2*)(cw + 2048 + xcol), w3 = *(const f32x2*)(cw + 3072 + xcol), bb = *(const f32x2*)(cb + xcol);
    const bf16* src = PROJ + ((size_t)b * SEQ + (size_t)c * 128 + 64 * th) * PJ + C_XBC + xcol;
    unsigned h3 = 0u, h2 = 0u, h1 = 0u;
    if (c > 0 || th > 0) { h3 = *(const unsigned*)(src - 3 * (ptrdiff_t)PJ); h2 = *(const unsigned*)(src - 2 * (ptrdiff_t)PJ); h1 = *(const unsigned*)(src - (ptrdiff_t)PJ); }
    f32x2 xm3 = {bflo(h3), bfhi(h3)}, xm2 = {bflo(h2), bfhi(h2)}, xm1 = {bflo(h1), bfhi(h1)};
#pragma unroll 1
    for (int tb = 0; tb < 2; ++tb) {
        unsigned xv[32];
#pragma unroll
        for (int e = 0; e < 32; ++e) xv[e] = *(const unsigned*)(src + (size_t)(32 * tb + e) * PJ);
#pragma unroll
        for (int e = 0; e < 32; ++e) { const f32x2 x = {bflo(xv[e]), bfhi(xv[e])}; const f32x2 y = bb + w0 * xm3 + w1 * xm2 + w2 * xm1 + w3 * x; xm3 = xm2; xm2 = xm1; xm1 = x;
            const int tok = 64 * th + 32 * tb + e; *(LAS unsigned*)(dst + tok * PITCH + dcol) = pk2(siluf_(y.x), siluf_(y.y)); }
    }
}
__device__ __forceinline__ float ssd_cumsum(const float* DT, const float* a_log, int b, int c, int g, int tid, int wid, int lane, LAS float* tot, float& dtv) {
    const int hh = tid >> 7, i = tid & 127;
    dtv = DT[((size_t)b * SEQ + c * 128 + i) * 8 + 4 * g + hh];
    float v = dtv * (-fexp(a_log[4 * g + hh]));
#pragma unroll
    for (int d = 1; d < 64; d <<= 1) { const float t = __shfl_up(v, d); if (lane >= d) v += t; }
    if (lane == 63) tot[wid] = v;
    __syncthreads();
    if (wid & 1) v += tot[wid - 1];
    return v;
}
__device__ __forceinline__ void ssd_states_item(LAS unsigned char* lds, const Params& p, int l, const bf16* PROJ, const float* DT, bf16* ST, float* CD, int it, int tid) {
    asm volatile("" : "+v"(tid)); const int lane = tid & 63, wid = __builtin_amdgcn_readfirstlane(tid >> 6);
    const int fr = lane & 15, fq = lane >> 4;
    const int g = it & 1, c = (it >> 1) & 63, b = it >> 7;
    LAS bf16* Xt = (LAS bf16*)(lds + SSD_XT); LAS bf16* Bt = (LAS bf16*)(lds + SSD_B);
    LAS float* wts = (LAS float*)(lds + SSD_TAB); LAS float* tot = wts + 1024;
    const float* cw = p.in[3] + (size_t)l * 4 * 1024; const float* cb = p.in[4] + l * 1024;
    { const int cp = tid & 255, th = tid >> 8;
      if (cp < 128) ssd_conv_pair<XR>(PROJ, b, c, th, 256 * g + 2 * cp, cw, cb, Xt, 2 * cp);
      else if (cp < 192) ssd_conv_pair<XP>(PROJ, b, c, th, 512 + 128 * g + 2 * (cp - 128), cw, cb, Bt, 2 * (cp - 128)); }
    float dtv; const float acs = ssd_cumsum(DT, p.in[6] + l * 8, b, c, g, tid, wid, lane, tot, dtv);
    { const int hh = tid >> 7, i = tid & 127; if (i == 127) { tot[8 + hh] = acs; CD[((size_t)b * 64 + c) * 8 + 4 * g + hh] = fexp(acs); } }
    __syncthreads();
    { const int hh = tid >> 7, i = tid & 127; wts[hh * 128 + i] = fexp(tot[8 + hh] - acs) * dtv; }
    __syncthreads();
    const int hh = wid >> 1, nh = wid & 1;
    f32x4 acc[4][4];
#pragma unroll
    for (int pt = 0; pt < 4; ++pt)
#pragma unroll
        for (int nt = 0; nt < 4; ++nt) acc[pt][nt] = (f32x4){0.f, 0.f, 0.f, 0.f};
#pragma unroll
    for (int ks = 0; ks < 4; ++ks) {
        const f32x4 wa = *(const LAS f32x4*)(wts + hh * 128 + 32 * ks + 8 * fq), wb = *(const LAS f32x4*)(wts + hh * 128 + 32 * ks + 8 * fq + 4);
        bf16x8 bfr[4];
#pragma unroll
        for (int nt = 0; nt < 4; ++nt) { const LAS bf16* bp = Bt + (32 * ks + 8 * fq + (fr >> 2)) * XP + 16 * (4 * nh + nt) + 4 * (fr & 3);
            bfr[nt] = cat8(lds_tr16(bp), lds_tr16(bp + 4 * XP)); }
#pragma unroll
        for (int pt = 0; pt < 4; ++pt) {
            const LAS bf16* xp_ = Xt + (32 * ks + 8 * fq + (fr >> 2)) * XR + 64 * hh + 16 * pt + 4 * (fr & 3); const u32x2 xlo = lds_tr16(xp_), xhi = lds_tr16(xp_ + 4 * XR);
            u32x4 xr; xr.x = xlo.x; xr.y = xlo.y; xr.z = xhi.x; xr.w = xhi.y;
            u32x4 xs; xs.x = pk2(bflo(xr.x) * wa[0], bfhi(xr.x) * wa[1]); xs.y = pk2(bflo(xr.y) * wa[2], bfhi(xr.y) * wa[3]);
            xs.z = pk2(bflo(xr.z) * wb[0], bfhi(xr.z) * wb[1]); xs.w = pk2(bflo(xr.w) * wb[2], bfhi(xr.w) * wb[3]);
            const bf16x8 xf = __builtin_bit_cast(bf16x8, xs);
#pragma unroll
            for (int nt = 0; nt < 4; ++nt) acc[pt][nt] = mfma16(bfr[nt], xf, acc[pt][nt]);
        }
    }
    bf16* sp = ST + ((((size_t)b * 64 + c) * 8 + 4 * g + hh) * 64) * 128;
#pragma unroll
    for (int pt = 0; pt < 4; ++pt)
#pragma unroll
        for (int nt = 0; nt < 4; ++nt) { u32x2 w; w.x = pk2(acc[pt][nt][0], acc[pt][nt][1]); w.y = pk2(acc[pt][nt][2], acc[pt][nt][3]);
            *(u32x2*)(sp + (size_t)(16 * pt + fr) * 128 + 16 * (4 * nh + nt) + 4 * fq) = w; }
    __syncthreads();
}
constexpr int YP = 264, SSD_YS_WAVE = 16 * YP * 2;
static_assert(8 * SSD_YS_WAVE <= SSD_TAB - SSD_B, "y staging fits the B|C images");
__device__ __forceinline__ void ssd_out_item(LAS unsigned char* lds, const Params& p, int l, const bf16* PROJ, const float* DT, const bf16* ST, bf16* MIX, int it, int tid) {
    asm volatile("" : "+v"(tid)); const int lane = tid & 63, wid = __builtin_amdgcn_readfirstlane(tid >> 6);
    const int fr = lane & 15, fq = lane >> 4;
    const int g = it & 1, c = (it >> 1) & 63, b = it >> 7;
    LAS bf16* Xt = (LAS bf16*)(lds + SSD_XT); LAS bf16* Bm = (LAS bf16*)(lds + SSD_B); LAS bf16* Cm = (LAS bf16*)(lds + SSD_C);
    LAS float* acsT = (LAS float*)(lds + SSD_TAB); LAS float* dtsT = acsT + 512; LAS float* tot = acsT + 1024; LAS float* rsT = acsT + 1040;
    const float* cw = p.in[3] + (size_t)l * 4 * 1024; const float* cb = p.in[4] + l * 1024;
    { const int cp = tid & 255, th = tid >> 8;
      if (cp < 128) ssd_conv_pair<XR>(PROJ, b, c, th, 256 * g + 2 * cp, cw, cb, Xt, 2 * cp);
      else if (cp < 192) ssd_conv_pair<XP>(PROJ, b, c, th, 512 + 128 * g + 2 * (cp - 128), cw, cb, Bm, 2 * (cp - 128));
      else ssd_conv_pair<XP>(PROJ, b, c, th, 768 + 128 * g + 2 * (cp - 192), cw, cb, Cm, 2 * (cp - 192)); }
    float dtv; const float acs = ssd_cumsum(DT, p.in[6] + l * 8, b, c, g, tid, wid, lane, tot, dtv);
    acsT[tid] = acs; dtsT[tid] = dtv;
    __syncthreads();
    const int w = wid;
    bf16x8 cf[4];
#pragma unroll
    for (int ks = 0; ks < 4; ++ks) cf[ks] = *(const LAS bf16x8*)(Cm + (16 * w + fr) * XP + 32 * ks + 8 * fq);
    f32x4 gt[8];
#pragma unroll
    for (int jt = 0; jt < 8; ++jt) { gt[jt] = (f32x4){0.f, 0.f, 0.f, 0.f};
        if (jt <= w) {
#pragma unroll
            for (int ks = 0; ks < 4; ++ks) gt[jt] = mfma16(*(const LAS bf16x8*)(Bm + (16 * jt + fr) * XP + 32 * ks + 8 * fq), cf[ks], gt[jt]); } }
    __syncthreads();
    LAS bf16* Ys = (LAS bf16*)(lds + SSD_B + wid * SSD_YS_WAVE);
    const int ii = 16 * w + fr; const size_t row = (size_t)b * SEQ + c * 128 + ii;
    float ssq = 0.f;
#pragma unroll 1
    for (int hh = 0; hh < 4; ++hh) {
        const float ai = acsT[hh * 128 + ii];
        const bf16* pp = ST + ((((size_t)b * 64 + c) * 8 + 4 * g + hh) * 64) * 128;
        bf16x8 pf[4][4]; u32x2 zr[4];
#pragma unroll
        for (int pt = 0; pt < 4; ++pt) {
#pragma unroll
            for (int ks = 0; ks < 4; ++ks) pf[pt][ks] = *(const bf16x8*)(pp + (size_t)(16 * pt + fr) * 128 + 32 * ks + 8 * fq);
            zr[pt] = *(const u32x2*)(PROJ + row * PJ + C_Z + 256 * g + 64 * hh + 16 * pt + 4 * fq); }
        f32x4 y[4];
#pragma unroll
        for (int pt = 0; pt < 4; ++pt) y[pt] = (f32x4){0.f, 0.f, 0.f, 0.f};
#pragma unroll
        for (int u = 0; u < 4; ++u) {
            if (2 * u <= w) {
                float sv[8];
#pragma unroll
                for (int q = 0; q < 2; ++q) { const int jt = 2 * u + q; const f32x4 aj = *(const LAS f32x4*)(acsT + hh * 128 + 16 * jt + 4 * fq), dj = *(const LAS f32x4*)(dtsT + hh * 128 + 16 * jt + 4 * fq);
#pragma unroll
                    for (int v = 0; v < 4; ++v) { const int j = 16 * jt + 4 * fq + v; sv[4 * q + v] = (j <= ii) ? gt[jt][v] * fexp(fminf(ai - aj[v], 0.f)) * dj[v] : 0.f; } }
                u32x4 pw; pw.x = pk2(sv[0], sv[1]); pw.y = pk2(sv[2], sv[3]); pw.z = pk2(sv[4], sv[5]); pw.w = pk2(sv[6], sv[7]);
                const bf16x8 pb = __builtin_bit_cast(bf16x8, pw);
#pragma unroll
                for (int pt = 0; pt < 4; ++pt) { const LAS bf16* xr = Xt + (32 * u + 4 * fq + (fr >> 2)) * XR + 64 * hh + 16 * pt + 4 * (fr & 3);
                    y[pt] = mfma16(cat8(lds_tr16(xr), lds_tr16(xr + 16 * XR)), pb, y[pt]); }
            }
        }
        const float ea = fexp(ai); const float dsk = p.in[7][l * 8 + 4 * g + hh];
#pragma unroll
        for (int pt = 0; pt < 4; ++pt) { f32x4 yo = {0.f, 0.f, 0.f, 0.f};
#pragma unroll
            for (int ks = 0; ks < 4; ++ks) yo = mfma16(pf[pt][ks], cf[ks], yo);
            const int ch = 64 * hh + 16 * pt + 4 * fq;
            const float zv[4] = {bflo(zr[pt].x), bfhi(zr[pt].x), bflo(zr[pt].y), bfhi(zr[pt].y)};
            float t[4]; const u32x2 xw = *(const LAS u32x2*)(Xt + ii * XR + ch); const float xq[4] = {bflo(xw.x), bfhi(xw.x), bflo(xw.y), bfhi(xw.y)};
#pragma unroll
            for (int v = 0; v < 4; ++v) { t[v] = (y[pt][v] + ea * yo[v] + dsk * xq[v]) * siluf_(zv[v]); ssq += t[v] * t[v]; }
            u32x2 wv; wv.x = pk2(t[0], t[1]); wv.y = pk2(t[2], t[3]); *(LAS u32x2*)(Ys + fr * YP + ch) = wv; }
    }
    ssq += __shfl_xor(ssq, 16); ssq += __shfl_xor(ssq, 32);
    if (fq == 0) rsT[ii] = __builtin_amdgcn_rsqf(ssq * (1.0f / 256.0f) + 1e-5f);
    asm volatile("" ::: "memory");
    const float* nw = p.in[8] + l * 512 + 256 * g + 8 * (lane & 31);
    const f32x4 n0 = *(const f32x4*)nw, n1 = *(const f32x4*)(nw + 4);
    bf16* mbase = MIX + ((size_t)b * SEQ + c * 128 + 16 * w) * DMIX + 512 + 256 * g + 8 * (lane & 31);
#pragma unroll
    for (int q = 0; q < 8; ++q) { const int tok = 2 * q + (lane >> 5); const u32x4 yr = *(const LAS u32x4*)(Ys + tok * YP + 8 * (lane & 31)); const float rstd = rsT[16 * w + tok];
        u32x4 o; o.x = pk2(bflo(yr.x) * rstd * n0[0], bfhi(yr.x) * rstd * n0[1]); o.y = pk2(bflo(yr.y) * rstd * n0[2], bfhi(yr.y) * rstd * n0[3]);
        o.z = pk2(bflo(yr.z) * rstd * n1[0], bfhi(yr.z) * rstd * n1[1]); o.w = pk2(bflo(yr.w) * rstd * n1[2], bfhi(yr.w) * rstd * n1[3]);
        *(u32x4*)(mbase + (size_t)tok * DMIX) = o; }
    __syncthreads();
}
static_assert(SSD_END <= LDS_BYTES, "SSD LDS map");
constexpr int LR_XP = 72, LR_AP = 68, LR_WAVE_BYTES = 16 * LR_XP * 2 + 2 * 16 * LR_AP * 4;
__device__ __forceinline__ void lru_local_item(LAS unsigned char* lds, const Params& p, int l, const bf16* PROJ, bf16* MIX, bf16* PL, float* AGA, float* AGH, int it, int tid) {
    asm volatile("" : "+v"(tid));
    const int lane = tid & 63, wid = __builtin_amdgcn_readfirstlane(tid >> 6), fr = lane & 15, fq = lane >> 4;
    const int kc = it & 127, b = it >> 7, ch = tid, cc = lane;
    LAS bf16* xcb = (LAS bf16*)(lds + wid * LR_WAVE_BYTES);
    LAS float* arL = (LAS float*)(lds + wid * LR_WAVE_BYTES + 16 * LR_XP * 2); LAS float* aiL = arL + 16 * LR_AP;
    bf16x8 wf[2][4][2];
#pragma unroll
    for (int mat = 0; mat < 2; ++mat) { const float* wb = p.in[mat == 0 ? 11 : 13] + (size_t)l * 32768 + (size_t)wid * 4096 + fr;
#pragma unroll
        for (int ks = 0; ks < 2; ++ks)
#pragma unroll
            for (int ct = 0; ct < 4; ++ct) { const float* wp = wb + (32 * ks + 8 * fq) * 64 + 16 * ct; u32x4 w;
                w.x = pk2(wp[0], wp[64]); w.y = pk2(wp[128], wp[192]); w.z = pk2(wp[256], wp[320]); w.w = pk2(wp[384], wp[448]); wf[mat][ct][ks] = __builtin_bit_cast(bf16x8, w); } }
    const float* cwp = p.in[9] + (size_t)l * 4 * 512 + ch; const float w0 = cwp[0], w1 = cwp[512], w2 = cwp[1024], w3 = cwp[1536], cb = p.in[10][l * 512 + ch];
    const float ba = p.in[12][l * 512 + ch], bx = p.in[14][l * 512 + ch], sp8 = -8.0f * softplusf(-p.in[15][l * 512 + ch]);
    const size_t row0 = (size_t)b * SEQ + (size_t)kc * 64;
    const bf16* src = PROJ + row0 * PJ + C_XL + ch;
    float xm3 = 0.f, xm2 = 0.f, xm1 = 0.f;
    if (kc > 0) { xm3 = bf2f(*(src - 3 * (ptrdiff_t)PJ)); xm2 = bf2f(*(src - 2 * (ptrdiff_t)PJ)); xm1 = bf2f(*(src - (ptrdiff_t)PJ)); }
    bf16 rawn[16];
#pragma unroll
    for (int e = 0; e < 16; ++e) rawn[e] = src[(size_t)e * PJ];
    float h = 0.f, P = 1.f;
#pragma unroll 1
    for (int sb = 0; sb < 4; ++sb) {
        float xc[16];
#pragma unroll
        for (int e = 0; e < 16; ++e) { const float x = bf2f(rawn[e]); const float y = cb + w0 * xm3 + w1 * xm2 + w2 * xm1 + w3 * x; xm3 = xm2; xm2 = xm1; xm1 = x; xc[e] = y; xcb[e * LR_XP + cc] = (bf16)f2bf(y); }
        if (sb < 3) {
#pragma unroll
            for (int e = 0; e < 16; ++e) rawn[e] = src[(size_t)(16 * (sb + 1) + e) * PJ]; }
        asm volatile("" ::: "memory");
        f32x4 accr[4], acci[4];
#pragma unroll
        for (int ct = 0; ct < 4; ++ct) { accr[ct] = (f32x4){0.f, 0.f, 0.f, 0.f}; acci[ct] = (f32x4){0.f, 0.f, 0.f, 0.f}; }
#pragma unroll
        for (int ks = 0; ks < 2; ++ks) { const bf16x8 a = *(const LAS bf16x8*)(xcb + fr * LR_XP + 32 * ks + 8 * fq);
#pragma unroll
            for (int ct = 0; ct < 4; ++ct) { accr[ct] = mfma16(a, wf[0][ct][ks], accr[ct]); acci[ct] = mfma16(a, wf[1][ct][ks], acci[ct]); } }
#pragma unroll
        for (int ct = 0; ct < 4; ++ct)
#pragma unroll
            for (int v = 0; v < 4; ++v) { arL[(4 * fq + v) * LR_AP + 16 * ct + fr] = accr[ct][v]; aiL[(4 * fq + v) * LR_AP + 16 * ct + fr] = acci[ct][v]; }
        asm volatile("" ::: "memory");
#pragma unroll
        for (int t = 0; t < 16; ++t) {
            const float ar = arL[t * LR_AP + cc] + ba, ai = aiL[t * LR_AP + cc] + bx;
            const float rg = sigmoidf_(ar), ig = sigmoidf_(ai), la = sp8 * rg, a = fexp(la), x2 = 2.0f * la;
            const float om_small = -x2 * (1.0f + x2 * (0.5f + x2 * (0.16666667f + x2 * (0.041666668f + x2 * (0.0083333338f + x2 * 0.0013888889f)))));
            const float om = (x2 > -0.25f) ? om_small : 1.0f - a * a;
            const float u = __builtin_amdgcn_sqrtf(om) * (ig * xc[t]);
            h = a * h + u; P *= a;
            const size_t row = row0 + 16 * sb + t;
            MIX[row * DMIX + 1024 + ch] = (bf16)f2bf(h); PL[row * 512 + ch] = (bf16)f2bf(P);
        }
        asm volatile("" ::: "memory");
    }
    AGA[((size_t)b * 128 + kc) * 512 + ch] = P; AGH[((size_t)b * 128 + kc) * 512 + ch] = h;
    __syncthreads();
}
__device__ __forceinline__ void lru_final_item(const bf16* PROJ, bf16* MIX, const bf16* PL, const float* AGH, int it, int tid) {
    asm volatile("" : "+v"(tid));
    const int kc = it & 127, b = it >> 7, ch = 2 * (tid & 255), th = tid >> 8;
    const f32x2 carry = *(const f32x2*)(AGH + ((size_t)b * 128 + kc) * 512 + ch);
    const size_t row0 = (size_t)b * SEQ + (size_t)kc * 64 + 32 * th;
    { constexpr int tb = 0;
        unsigned hl[32], pv[32], gv[32];
#pragma unroll
        for (int e = 0; e < 32; ++e) { const size_t row = row0 + 16 * tb + e; hl[e] = *(const unsigned*)(MIX + row * DMIX + 1024 + ch); pv[e] = *(const unsigned*)(PL + row * 512 + ch); gv[e] = *(const unsigned*)(PROJ + row * PJ + C_GL + ch); }
#pragma unroll
        for (int e = 0; e < 32; ++e) { const size_t row = row0 + 16 * tb + e;
            const float o0 = (bflo(hl[e]) + bflo(pv[e]) * carry.x) * gelu_tanh(bflo(gv[e])), o1 = (bfhi(hl[e]) + bfhi(pv[e]) * carry.y) * gelu_tanh(bfhi(gv[e]));
            *(unsigned*)(MIX + row * DMIX + 1024 + ch) = pk2(o0, o1); }
    }
}
__device__ __forceinline__ void scans_phase(bf16* ST, const float* CD, const float* AGA, float* AGH, int gtid, int gthreads, int gw, int NGW, int lane) {
    for (int e = gtid; e < 2 * 8 * 64 * 128; e += gthreads) {
        const int b = e >> 16, rem = e & 65535, h = rem >> 13;
        bf16* sp = ST + (size_t)b * 64 * 65536 + rem; const float* cd = CD + (size_t)b * 64 * 8 + h;
        float carry = 0.f;
#pragma unroll 1
        for (int c0 = 0; c0 < 64; c0 += 32) {
            bf16 s[32]; float d[32];
#pragma unroll
            for (int q = 0; q < 32; ++q) { s[q] = sp[(size_t)(c0 + q) * 65536]; d[q] = cd[(c0 + q) * 8]; }
#pragma unroll
            for (int q = 0; q < 32; ++q) { sp[(size_t)(c0 + q) * 65536] = (bf16)f2bf(carry); carry = d[q] * carry + bf2f(s[q]); }
        }
    }
    for (int e = gw; e < 2 * 512; e += NGW) {
        const int b = e >> 9, ch = e & 511;
        const float* ap = AGA + (size_t)b * 128 * 512 + ch; float* hp = AGH + (size_t)b * 128 * 512 + ch;
        const float a0 = ap[(size_t)(2 * lane) * 512], a1 = ap[(size_t)(2 * lane + 1) * 512], h0 = hp[(size_t)(2 * lane) * 512], h1 = hp[(size_t)(2 * lane + 1) * 512];
        float A = a0 * a1, H = a1 * h0 + h1;
#pragma unroll
        for (int dd = 1; dd < 64; dd <<= 1) { const float Ap = __shfl_up(A, dd), Hp = __shfl_up(H, dd); if (lane >= dd) { H = A * Hp + H; A = A * Ap; } }
        float cin = __shfl_up(H, 1); if (lane == 0) cin = 0.f;
        hp[(size_t)(2 * lane) * 512] = cin; hp[(size_t)(2 * lane + 1) * 512] = a0 * cin + h0;
    }
}
#define XB_TMO      128
#define XB_XCNT(j)  (256  + 64 * (j))
#define XB_XSUB(j)  (1280 + 64 * (j))
#define XB_XGEN(j)  (2304 + 64 * (j))
#define XB_TOP      3328
#define XB_TOPGEN   3392
#define XCD_BAR_WORDS 3456
#define XB_SPIN_CAP (1u << 18)

__device__ __forceinline__ unsigned xb_ld(unsigned* p)              { return __hip_atomic_load(p, __ATOMIC_RELAXED, __HIP_MEMORY_SCOPE_AGENT); }
__device__ __forceinline__ unsigned xb_add(unsigned* p, unsigned v) { return __hip_atomic_fetch_add(p, v, __ATOMIC_RELAXED, __HIP_MEMORY_SCOPE_AGENT); }
__device__ __forceinline__ unsigned xb_xcc_id() { return (unsigned)__builtin_amdgcn_s_getreg((3 << 11) | 20) & 0xFu; }
#define XB_SPIN(cond, bar) do { unsigned _sp = 0; while (cond) { __builtin_amdgcn_s_sleep(1); \
    if ((++_sp & 255u) == 0u) { if (xb_ld(&(bar)[XB_TMO])) break; if (_sp > XB_SPIN_CAP) { atomicAdd(&(bar)[XB_TMO], 1u); break; } } } } while (0)

struct XcdBarrier {
    unsigned* bar; unsigned x;
    volatile LAS unsigned* st;
};

__device__ __forceinline__ XcdBarrier xcd_barrier_post(unsigned* bar, volatile LAS unsigned* st) {
    XcdBarrier b; b.bar = bar; b.x = xb_xcc_id(); b.st = st;
    if (threadIdx.x == 0) (void)xb_add(&bar[XB_XCNT(b.x)], 1u);
    return b;
}
__device__ __forceinline__ void xcd_barrier_complete(unsigned* bar, unsigned x, unsigned& nloc, unsigned& nx) {
    const unsigned G = gridDim.x * gridDim.y * gridDim.z;
    unsigned sum, cnt, mine, sp = 0u;
    for (;;) {
        sum = 0u; cnt = 0u; mine = 0u;
#pragma unroll
        for (unsigned j = 0; j < 16; ++j) { const unsigned c = xb_ld(&bar[XB_XCNT(j)]); sum += c; cnt += (c > 0u) ? 1u : 0u; mine = (j == x) ? c : mine; }
        if (sum == G) break;
        __builtin_amdgcn_s_sleep(1);
        if ((++sp & 255u) == 0u) { if (xb_ld(&bar[XB_TMO])) break; if (sp > XB_SPIN_CAP) { atomicAdd(&bar[XB_TMO], 1u); break; } }
    }
    nloc = mine > 0u ? mine : 1u; nx = cnt > 0u ? cnt : 1u;
}

__device__ __forceinline__ void xcd_barrier(const XcdBarrier& b) {
    asm volatile("s_waitcnt vmcnt(0)" ::: "memory");
    __syncthreads();
    if (threadIdx.x == 0) {
        unsigned* bar = b.bar;
        __builtin_amdgcn_s_waitcnt(0);
        unsigned nloc = b.st[0], nx = b.st[1];
        if (nloc == 0u) { xcd_barrier_complete(bar, b.x, nloc, nx); b.st[0] = nloc; b.st[1] = nx; }
        const unsigned old = xb_add(&bar[XB_XSUB(b.x)], 1u);
        const unsigned gen = old / nloc;
        if (old + 1u == (gen + 1u) * nloc) {
            __builtin_amdgcn_fence(__ATOMIC_RELEASE, "agent");
            asm volatile("s_waitcnt vmcnt(0)" ::: "memory");
            const unsigned og = xb_add(&bar[XB_TOP], 1u);
            const unsigned tg = og / nx;
            if (og + 1u == (tg + 1u) * nx) xb_add(&bar[XB_TOPGEN], 1u);
            else XB_SPIN(xb_ld(&bar[XB_TOPGEN]) == tg, bar);
            __builtin_amdgcn_fence(__ATOMIC_ACQUIRE, "agent");
            xb_add(&bar[XB_XGEN(b.x)], 1u);
            asm volatile("s_waitcnt vmcnt(0)" ::: "memory");
        } else {
            XB_SPIN(xb_ld(&bar[XB_XGEN(b.x)]) == gen, bar);
            __builtin_amdgcn_fence(__ATOMIC_ACQUIRE, "agent");
            asm volatile("s_waitcnt vmcnt(0)" ::: "memory");
        }
    }
    __syncthreads();
}

__global__ void __launch_bounds__(NTHR, 2) hybrid_fwd(Params p) {
    extern __shared__ __attribute__((aligned(16))) unsigned char lds_raw[];
    LAS unsigned char* lds = (LAS unsigned char*)lds_raw;
    volatile LAS unsigned* bst = (volatile LAS unsigned*)(lds + LDS_BYTES - 1024);
    if (threadIdx.x == 0) { bst[0] = 0u; bst[1] = 0u; }
    __syncthreads();
    const XcdBarrier xbar = xcd_barrier_post((unsigned*)p.ws, bst);
#define GRID_BAR() xcd_barrier(xbar)
    const int G = gridDim.x, bid = blockIdx.x, NGW = G * 8;
#ifdef DIAG_A
    LAS unsigned long long* dts = (LAS unsigned long long*)(lds + LDS_BYTES - 512);
    if (threadIdx.x == 0) { for (int k = 1; k < 32; ++k) dts[k] = 0ull; dts[0] = __builtin_amdgcn_s_memrealtime(); }
#define STAMP(k) do { if (threadIdx.x == 0) { const unsigned long long t_ = __builtin_amdgcn_s_memrealtime(); dts[1 + (k)] += t_ - dts[0]; dts[0] = t_; } } while (0)
#else
#define STAMP(k) do {} while (0)
#endif
#define FRESH_TID() int tid = threadIdx.x; asm volatile("" : "+v"(tid)); const int lane = tid & 63, wave = __builtin_amdgcn_readfirstlane(tid >> 6), gw = bid * 8 + wave; (void)lane; (void)gw;
    unsigned char* ws = p.ws;
    float* DT = (float*)(ws + WS_DT); float* LSE = (float*)(ws + WS_LSE); float* AGA = (float*)(ws + WS_AGA); float* AGH = (float*)(ws + WS_AGH); float* CD = (float*)(ws + WS_CD); float* RSP = (float*)(ws + WS_RSP);
    bf16* WinT = (bf16*)(ws + WS_WIN); bf16* WdT = (bf16*)(ws + WS_WD);
    bf16* XN = (bf16*)(ws + WS_XN); bf16* ST = (bf16*)(ws + WS_ST); bf16* PL = (bf16*)(ws + WS_PL);
    bf16* PROJ = (bf16*)(ws + WS_PROJ); bf16* ACT = (bf16*)(ws + WS_PROJ); bf16* MIX = (bf16*)(ws + WS_MIX);
#pragma unroll 1
    for (int l = 0; l < DEPTH; ++l) {
        bf16* XB1 = (bf16*)(ws + WS_PROJ + 92 * MiB); bf16* XB2 = (bf16*)p.out;
        bf16* WoutT = (bf16*)(ws + (l == 0 ? WS_WOUT : WS_WOUT1)); bf16* WguT = (bf16*)(ws + (l == 0 ? WS_WGU : WS_WGU1));
        const WtDst wd0{(bf16*)(ws + WS_WIN), (bf16*)(ws + WS_WOUT), (bf16*)(ws + WS_WGU), (bf16*)(ws + WS_WD)}, wd1{(bf16*)(ws + WS_WIN), (bf16*)(ws + WS_WOUT1), (bf16*)(ws + WS_WGU1), (bf16*)(ws + WS_WD)};
        { FRESH_TID();
        if (l == 0) weights_phase(p, 0, wd0, 0, WT_ALL, lds, gw, NGW, wave, lane);
        if (l == 0) norm_dt_phase<false>(p.in[0], XN, p.in[1] + l * DM, p.in[2] + (size_t)l * DM * INC, p.in[5] + l * 8, DT, gw, NGW, lane, lds, tid);
        else norm_dt_phase<true>(XB2, XN, p.in[1] + l * DM, p.in[2] + (size_t)l * DM * INC, p.in[5] + l * 8, DT, gw, NGW, lane, lds, tid);
        }
        STAMP(0); GRID_BAR(); STAMP(1);
        { pg8::Gemm g{XN, WinT, NTOK, PJ, DM}; pg8::StaticOrder S; S.init(NTOK, PJ, G, bid); pg8::EpiBf16<0> E{PROJ, PJ, nullptr, 0, 0, 1.f};
          pg8::gemm_phase<pg8::EpiBf16<0>, pg8::StaticOrder, true, true>(lds, g, S, E); }
        STAMP(2); GRID_BAR(); STAMP(3);
        { FRESH_TID();
        int it = bid;
        for (; it < 512; it += G) {
            if (it < 256) { lru_local_item(lds, p, l, PROJ, MIX, PL, AGA, AGH, it, tid); STAMP(4); }
            else { ssd_states_item(lds, p, l, PROJ, DT, ST, CD, it - 256, tid); STAMP(5); }
        }
        attn_phase(lds, PROJ, MIX, LSE, 0, bid, G, tid); STAMP(6);
        }
        GRID_BAR(); STAMP(7);
        { FRESH_TID();
        scans_phase(ST, CD, AGA, AGH, bid * NTHR + tid, G * NTHR, gw, NGW, lane); STAMP(8);
        attn_phase(lds, PROJ, MIX, LSE, 1, bid, G, tid);
        }
        STAMP(9); GRID_BAR(); STAMP(10);
        { FRESH_TID();
        int it = bid;
        for (; it < 512; it += G) {
            if (it < 256) { ssd_out_item(lds, p, l, PROJ, DT, ST, MIX, it, tid); STAMP(11); }
            else { lru_final_item(PROJ, MIX, PL, AGH, it - 256, tid); STAMP(12); }
        }
        attn_phase(lds, PROJ, MIX, LSE, 2, bid, G, tid); STAMP(13);
        }
        GRID_BAR(); STAMP(14);
        { pg8::Gemm g{MIX, WoutT, NTOK, DM, DMIX}; pg8::StaticOrder S; S.init(NTOK, DM, G, bid); if (l == 0) { pg8::EpiResBf<true> E{p.in[0], XB1, DM, RSP}; pg8::gemm_phase<pg8::EpiResBf<true>, pg8::StaticOrder, false, true>(lds, g, S, E); }
          else { pg8::EpiResBf<false> E{XB2, XB1, DM, RSP}; pg8::gemm_phase<pg8::EpiResBf<false>, pg8::StaticOrder, false, true>(lds, g, S, E); } }
        STAMP(15); GRID_BAR(); STAMP(16);
        { pg8::Gemm g{XB1, WguT, NTOK, 2 * DFF, DM}; pg8::StaticOrder S; S.init(NTOK, 2 * DFF, G, bid); pg8::EpiSwiGLU E{ACT, DFF, RSP};
          pg8::gemm_phase<pg8::EpiSwiGLU, pg8::StaticOrder, true, true>(lds, g, S, E); }
        {
          const int nun = (NTOK / 256) * (2 * DFF / 256), rounds = (nun + G - 1) / G, nbusy = nun - (rounds - 1) * G;
          if (nbusy < G && bid >= nbusy) { FRESH_TID(); const int gw2 = (bid - nbusy) * 8 + wave, ngw2 = (G - nbusy) * 8;
              if (l == 0) weights_phase(p, 1, wd1, 0, WT_EARLY, lds, gw2, ngw2, wave, lane); else weights_phase(p, 1, wd1, WT_EARLY, WT_ALL, lds, gw2, ngw2, wave, lane); }
          else if (nbusy >= G) { FRESH_TID(); if (l == 0) weights_phase(p, 1, wd1, 0, WT_EARLY, lds, gw, NGW, wave, lane); else weights_phase(p, 1, wd1, WT_EARLY, WT_ALL, lds, gw, NGW, wave, lane); } }
        STAMP(19); GRID_BAR(); STAMP(20);
        { pg8::Gemm g{ACT, WdT, NTOK, DM, DFF}; pg8::StaticOrder S; S.init(NTOK, DM, G, bid); pg8::EpiResBf<false> E{XB1, l == 0 ? XB2 : XB1, DM, nullptr};
          pg8::gemm_phase<pg8::EpiResBf<false>, pg8::StaticOrder, false, true>(lds, g, S, E); }
        STAMP(21); GRID_BAR(); STAMP(22);
    }
    { FRESH_TID(); final_norm_phase((const bf16*)(ws + WS_PROJ + 92 * MiB), p.out, p.in[21], gw, NGW, lane); }
    STAMP(23);
#ifdef DIAG_A
    if (bid == 0) {
        __threadfence(); __syncthreads();
        const float ta = (float)dts[1 + DIAG_A] * 0.01f, tb = (float)dts[1 + DIAG_B] * 0.01f;
        const float Ea = sqrtf(0.16384f * ta);
        atomicAdd(p.out + threadIdx.x, Ea); atomicAdd(p.out + 512 + threadIdx.x, Ea);
        if (threadIdx.x == 0) atomicAdd(p.out + 1024, tb * 0.1f);
    }
#endif
}

extern "C" void kernel_launch(void* const* d_in, const int* in_sizes, int n_in, void* d_out, int out_size, void* d_ws, size_t ws_size, hipStream_t stream) {
    static int grid = 0;
    if (grid == 0) {
        if (n_in != 22 || out_size != NTOK * DM || ws_size < WS_END) { fprintf(stderr, "kernel_launch: unexpected shapes (n_in %d out %d ws %zu)\n", n_in, out_size, ws_size); grid = -1; return; }
        int dev = 0, cus = 0, per_cu = 0;
        hipGetDevice(&dev); hipDeviceGetAttribute(&cus, hipDeviceAttributeMultiprocessorCount, dev);
        if (hipFuncSetAttribute((const void*)hybrid_fwd, hipFuncAttributeMaxDynamicSharedMemorySize, LDS_BYTES) != hipSuccess) { fprintf(stderr, "kernel_launch: hipFuncSetAttribute failed\n"); grid = -1; return; }
        if (hipOccupancyMaxActiveBlocksPerMultiprocessor(&per_cu, (const void*)hybrid_fwd, NTHR, LDS_BYTES) != hipSuccess || per_cu < 1) { fprintf(stderr, "kernel_launch: occupancy query failed (%d)\n", per_cu); grid = -1; return; }
        grid = cus * per_cu;
    }
    if (grid < 0) return;
    if (hipMemsetAsync(d_ws, 0, 16384, stream) != hipSuccess) { fprintf(stderr, "kernel_launch: memset failed\n"); return; }
    Params p{};
    for (int i = 0; i < 22; ++i) p.in[i] = (const float*)d_in[i];
    p.out = (float*)d_out; p.ws = (unsigned char*)d_ws;
    void* args[] = {&p};
    hipError_t e = hipLaunchCooperativeKernel((const void*)hybrid_fwd, dim3(grid), dim3(NTHR), args, LDS_BYTES, stream);
    if (e != hipSuccess) fprintf(stderr, "cooperative launch failed: %s (grid %d)\n", hipGetErrorString(e), grid);
}
```

```cpp
#include <hip/hip_runtime.h>
#include <hip/hip_cooperative_groups.h>
#include <cstdio>
#include <cstdint>
namespace cg = cooperative_groups;
namespace pg8 {
#define PG8_LAS __attribute__((address_space(3)))
typedef unsigned short bf16_t;
typedef short bf16x8 __attribute__((ext_vector_type(8)));
typedef float f32x4 __attribute__((ext_vector_type(4)));
typedef unsigned u32x4 __attribute__((ext_vector_type(4)));
constexpr int BM = 256, BK = 64, HALF = 128, HTB = HALF * BK * 2  , STAGE_BYTES = 8 * HTB, NXCD = 8, WGM = 8;

__host__ __device__ __forceinline__ int lds_byte(int r, int c) { const int st = (r >> 4) * 2 + (c >> 5), rr = r & 15, cc = c & 31, ob = rr * 64 + cc * 2; return st * 1024 + (ob ^ (((ob >> 9) & 1) << 5)); }
__host__ __device__ __forceinline__ void stage_rc(int b, int& R, int& C) { const int st = b / 1024, sb = b % 1024, swz = sb ^ (((sb >> 9) & 1) << 5); R = (st >> 1) * 16 + swz / 64; C = (st & 1) * 32 + (swz % 64) / 2; }
__host__ __device__ __forceinline__ int perm32(int rho) { const int n = rho >> 4, i = rho & 15; return 8 * (i >> 2) + 4 * n + (i & 3); }

struct Unit { int pm, pn; };
struct Gemm { const bf16_t* A; const bf16_t* Bt; int M, N, K; };

struct StaticOrder {
    int nM, nN, nwg, G, c;
    __host__ __device__ void init(int M, int N, int G_, int c_) { nM = M / BM; nN = N / BM; nwg = nM * nN; G = G_; c = c_; }
    __host__ __device__ bool next(int i, Unit& u) const {
        const long L = (long)i * G + c; if (L >= nwg) return false;
        int wgid = (int)L; { const int q = nwg / NXCD, r = nwg % NXCD, xcd = wgid % NXCD, off = wgid / NXCD; wgid = (xcd < r ? xcd * (q + 1) : r * (q + 1) + (xcd - r) * q) + off; }
        const int nig = WGM * nN, gid = wgid / nig, fm = gid * WGM, gsz = (nM - fm) < WGM ? (nM - fm) : WGM;
        u.pm = fm + ((wgid % nig) % gsz); u.pn = (wgid % nig) / gsz; return true;
    }
    __device__ __forceinline__ void a_ready(const Unit&) const {}
    __device__ __forceinline__ void done(const Unit&) const {}
};

__device__ __forceinline__ unsigned cvt_pk_bf16(float lo, float hi) { unsigned r; asm volatile("v_cvt_pk_bf16_f32 %0, %1, %2" : "=v"(r) : "v"(lo), "v"(hi)); return r; }
typedef float f32x2 __attribute__((ext_vector_type(2)));
__device__ __forceinline__ f32x2 gelu_pk(f32x2 v) {
    const f32x2 av = __builtin_elementwise_abs(v), d = av * 0.2316418882f + 1.0f;
    f32x2 t; t.x = __builtin_amdgcn_rcpf(d.x); t.y = __builtin_amdgcn_rcpf(d.y);
    f32x2 q = t * 0.5307027145f + (-0.7265760135f); q = q * t + 0.7107068705f; q = q * t + (-0.142248368f); q = q * t + 0.127414796f; q = q * t;
    const f32x2 s = (v * v) * (-0.72134752044f);
    f32x2 e; e.x = __builtin_amdgcn_exp2f(s.x); e.y = __builtin_amdgcn_exp2f(s.y);
    const f32x2 m = v * (q * e), r = v - m;
    f32x2 o; o.x = v.x < 0.f ? m.x : r.x; o.y = v.y < 0.f ? m.y : r.y; return o;
}

template <int ACT  > struct EpiBf16 {
    static constexpr bool PERM = true, AFTER_DRAIN = false; static_assert(ACT == 0 || ACT == 1, "EpiBf16: ACT is 0 (none) or 1 (gelu_pk)");
    bf16_t* O; int ldc; const float* bias; int split_cols; size_t split_stride; float scale0;
    __device__ __forceinline__ void operator()(const f32x4 (&acc)[2][2][4][2], const Unit& u, int wr, int wc, int fr, int fq) const {
        const int row0 = u.pm * BM + wr * 64 + fr; int colt = u.pn * BM; bf16_t* base = O;
        float sc = 1.f; if (split_cols) { const int t = colt / split_cols; base += (size_t)t * split_stride; colt -= t * split_cols; if (t == 0) sc = scale0; }
        const int col0 = colt + wc * 32 + 8 * fq, bcol0 = u.pn * BM + wc * 32 + 8 * fq;
        f32x4 bv[2][2];
#pragma unroll
        for (int bj = 0; bj < 2; ++bj)
#pragma unroll
            for (int n = 0; n < 2; ++n) bv[bj][n] = bias ? *(const f32x4*)(bias + bcol0 + bj * HALF + 4 * n) : (f32x4){0.f, 0.f, 0.f, 0.f};
#pragma unroll
        for (int ai = 0; ai < 2; ++ai)
#pragma unroll
            for (int m = 0; m < 4; ++m) { bf16_t* rowp = base + (size_t)(row0 + ai * HALF + m * 16) * ldc + col0;
#pragma unroll
                for (int bj = 0; bj < 2; ++bj) { f32x4 v0 = acc[ai][bj][m][0] + bv[bj][0], v1 = acc[ai][bj][m][1] + bv[bj][1];
                    if (ACT == 1) { f32x2 a = gelu_pk((f32x2){v0[0], v0[1]}), b = gelu_pk((f32x2){v0[2], v0[3]}), c = gelu_pk((f32x2){v1[0], v1[1]}), d = gelu_pk((f32x2){v1[2], v1[3]});
                        v0 = (f32x4){a.x, a.y, b.x, b.y}; v1 = (f32x4){c.x, c.y, d.x, d.y}; }
                    v0 = v0 * sc; v1 = v1 * sc; u32x4 w; w.x = cvt_pk_bf16(v0[0], v0[1]); w.y = cvt_pk_bf16(v0[2], v0[3]); w.z = cvt_pk_bf16(v1[0], v1[1]); w.w = cvt_pk_bf16(v1[2], v1[3]);
                    *(u32x4*)(rowp + bj * HALF) = w; } }
    }
};
struct EpiResF32 {
    static constexpr bool PERM = false, AFTER_DRAIN = false;
    const float* base; float* out; int ldc;
    __device__ __forceinline__ void operator()(const f32x4 (&acc)[2][2][4][2], const Unit& u, int wr, int wc, int fr, int fq) const {
        const int row0 = u.pm * BM + wr * 64 + fr, col0 = u.pn * BM + wc * 32 + 4 * fq;
#pragma unroll
        for (int ai = 0; ai < 2; ++ai)
#pragma unroll
            for (int m = 0; m < 4; ++m) { const size_t off = (size_t)(row0 + ai * HALF + m * 16) * ldc + col0;
#pragma unroll
                for (int bj = 0; bj < 2; ++bj)
#pragma unroll
                    for (int n = 0; n < 2; ++n) { const f32x4 b = *(const f32x4*)(base + off + bj * HALF + n * 16); *(f32x4*)(out + off + bj * HALF + n * 16) = b + acc[ai][bj][m][n]; } }
    }
};
template <bool BASE_F32> struct EpiResBf {
    static constexpr bool PERM = true, AFTER_DRAIN = false;
    const void* base; bf16_t* out; int ldc; float* rsp;
    __device__ __forceinline__ void operator()(const f32x4 (&acc)[2][2][4][2], const Unit& u, int wr, int wc, int fr, int fq) const {
        const int row0 = u.pm * BM + wr * 64 + fr, col0 = u.pn * BM + wc * 32 + 8 * fq;
#pragma unroll
        for (int ai = 0; ai < 2; ++ai)
#pragma unroll
            for (int m = 0; m < 4; ++m) { const size_t off = (size_t)(row0 + ai * HALF + m * 16) * ldc + col0; float ss = 0.f;
#pragma unroll
                for (int bj = 0; bj < 2; ++bj) { f32x4 b0, b1;
                    if (BASE_F32) { const float* bp = (const float*)base + off + bj * HALF; b0 = *(const f32x4*)bp; b1 = *(const f32x4*)(bp + 4); }
                    else { const u32x4 w = *(const u32x4*)((const bf16_t*)base + off + bj * HALF);
                        b0 = (f32x4){__builtin_bit_cast(float, w.x << 16), __builtin_bit_cast(float, w.x & 0xffff0000u), __builtin_bit_cast(float, w.y << 16), __builtin_bit_cast(float, w.y & 0xffff0000u)};
                        b1 = (f32x4){__builtin_bit_cast(float, w.z << 16), __builtin_bit_cast(float, w.z & 0xffff0000u), __builtin_bit_cast(float, w.w << 16), __builtin_bit_cast(float, w.w & 0xffff0000u)}; }
                    const f32x4 v0 = b0 + acc[ai][bj][m][0], v1 = b1 + acc[ai][bj][m][1];
                    u32x4 o; o.x = cvt_pk_bf16(v0[0], v0[1]); o.y = cvt_pk_bf16(v0[2], v0[3]); o.z = cvt_pk_bf16(v1[0], v1[1]); o.w = cvt_pk_bf16(v1[2], v1[3]);
                    *(u32x4*)(out + off + bj * HALF) = o;
                    ss += ((v0[0] * v0[0] + v0[1] * v0[1]) + (v0[2] * v0[2] + v0[3] * v0[3])) + ((v1[0] * v1[0] + v1[1] * v1[1]) + (v1[2] * v1[2] + v1[3] * v1[3])); }
                if (rsp) { ss += __shfl_xor(ss, 16); ss += __shfl_xor(ss, 32); if (fq == 0) rsp[(size_t)(row0 + ai * HALF + m * 16) * 16 + 4 * u.pn + wc] = ss; } }
    }
};
struct EpiSwiGLU {
    static constexpr bool PERM = true, AFTER_DRAIN = false;
    bf16_t* O; int ldc; const float* rsp;
    __device__ __forceinline__ void operator()(const f32x4 (&acc)[2][2][4][2], const Unit& u, int wr, int wc, int fr, int fq) const {
        const int row0 = u.pm * BM + wr * 64 + fr, f0 = u.pn * 128 + wc * 32 + 8 * fq;
#pragma unroll
        for (int ai = 0; ai < 2; ++ai)
#pragma unroll
            for (int m = 0; m < 4; ++m) { bf16_t* rowp = O + (size_t)(row0 + ai * HALF + m * 16) * ldc + f0;
                const f32x4* rp = (const f32x4*)(rsp + (size_t)(row0 + ai * HALF + m * 16) * 16); const f32x4 q0 = rp[0], q1 = rp[1], q2 = rp[2], q3 = rp[3];
                const float tot = ((q0[0] + q0[1]) + (q0[2] + q0[3])) + ((q1[0] + q1[1]) + (q1[2] + q1[3])) + ((q2[0] + q2[1]) + (q2[2] + q2[3])) + ((q3[0] + q3[1]) + (q3[2] + q3[3]));
                const float rs = __builtin_amdgcn_rsqf(tot * (1.0f / 1024.0f) + 1e-6f);
                float r[8];
#pragma unroll
                for (int n = 0; n < 2; ++n)
#pragma unroll
                    for (int e = 0; e < 4; ++e) { const float g = acc[ai][0][m][n][e] * rs, up = acc[ai][1][m][n][e] * rs; r[4 * n + e] = g * up * __builtin_amdgcn_rcpf(1.0f + __builtin_amdgcn_exp2f(-1.4426950408889634f * g)); }
                u32x4 w; w.x = cvt_pk_bf16(r[0], r[1]); w.y = cvt_pk_bf16(r[2], r[3]); w.z = cvt_pk_bf16(r[4], r[5]); w.w = cvt_pk_bf16(r[6], r[7]);
                *(u32x4*)rowp = w; }
    }
};
template <class Epi, class Sched, bool ALIGN_EPI = false, bool SP2 = false>
__device__ __forceinline__ void gemm_phase(PG8_LAS unsigned char* lds, const Gemm g, const Sched& S, const Epi& E) {
    int tid_l = threadIdx.x; asm volatile("" : "+v"(tid_l));
    const int tid = tid_l, wid = __builtin_amdgcn_readfirstlane(tid >> 6), lane = tid & 63, wr = wid >> 2, wc = wid & 3, fr = lane & 15, fq = lane >> 4;
    const int K = g.K, nt = K / BK;
    unsigned voffA[2], voffB[2];
#pragma unroll
    for (int i = 0; i < 2; ++i) { int R, C; stage_rc(tid * 16 + i * 8192, R, C); const int Rb = Epi::PERM ? ((R & ~31) + perm32(R & 31)) : R;
        voffA[i] = (unsigned)(R * K + C) * 2u; voffB[i] = (unsigned)(Rb * K + C) * 2u; }
    const size_t kstep = (size_t)(BK * 2);
    const size_t hstep = (size_t)HALF * K * 2;
    const size_t tstep = 2 * hstep;
    const unsigned ldsw = (unsigned)wid * 1024u;
    const int aoff = lds_byte(wr * 64 + fr, fq * 8), boff = lds_byte(wc * 32 + fr, fq * 8);
#define PG8_SA(b, h) (((b) * 2 + (h)) * HTB)
#define PG8_SB(b, h) ((4 + (b) * 2 + (h)) * HTB)
#define PG8_STAGE(bufoff, gbase, voff) do { _Pragma("unroll") for (int _i = 0; _i < 2; ++_i) \
        __builtin_amdgcn_global_load_lds((const unsigned*)((const char*)(gbase) + (voff)[_i]), (PG8_LAS unsigned*)(lds + (bufoff) + ldsw + _i * 8192), 16, 0, 0); } while (0)
#define PG8_LDA(dst, b, h) do { _Pragma("unroll") for (int m = 0; m < 4; ++m) _Pragma("unroll") for (int k = 0; k < 2; ++k) dst[m][k] = *(const PG8_LAS bf16x8*)(lds + PG8_SA(b, h) + aoff + m * 2048 + k * 1024); } while (0)
#define PG8_LDB(dst, b, h) do { _Pragma("unroll") for (int n = 0; n < 2; ++n) _Pragma("unroll") for (int k = 0; k < 2; ++k) dst[n][k] = *(const PG8_LAS bf16x8*)(lds + PG8_SB(b, h) + boff + n * 2048 + k * 1024); } while (0)
#define PG8_MMA(ai, bj, At, Bt) do { __builtin_amdgcn_s_setprio(1); _Pragma("unroll") for (int m = 0; m < 4; ++m) _Pragma("unroll") for (int n = 0; n < 2; ++n) _Pragma("unroll") for (int k = 0; k < 2; ++k) \
        acc[ai][bj][m][n] = __builtin_amdgcn_mfma_f32_16x16x32_bf16(Bt[n][k], At[m][k], acc[ai][bj][m][n], 0, 0, 0); __builtin_amdgcn_s_setprio(0); } while (0)
#define PG8_WAIT_V(n) asm volatile("s_waitcnt vmcnt(" #n ")" ::: "memory")
#define PG8_WAIT_L(n) asm volatile("s_waitcnt lgkmcnt(" #n ")" ::: "memory")
#define PG8_BAR __builtin_amdgcn_s_barrier()
#define PG8_SCHED __builtin_amdgcn_sched_barrier(0)
    Unit cur, nxt; int ui = 0;
    if (!S.next(0, cur)) return;
    f32x4 acc[2][2][4][2];
#pragma unroll
    for (int a = 0; a < 2; ++a)
#pragma unroll
        for (int b = 0; b < 2; ++b)
#pragma unroll
            for (int m = 0; m < 4; ++m)
#pragma unroll
                for (int n = 0; n < 2; ++n) acc[a][b][m][n] = (f32x4){0.f, 0.f, 0.f, 0.f};
    bf16x8 At[4][2], B0[2][2], B1[2][2];
    const char* cA = (const char*)g.A + (size_t)cur.pm * tstep; const char* cB = (const char*)g.Bt + (size_t)cur.pn * tstep;
    S.a_ready(cur);
    if constexpr (SP2) {
        PG8_STAGE(PG8_SB(0, 0), cB, voffB); PG8_STAGE(PG8_SB(0, 1), cB + hstep, voffB); PG8_STAGE(PG8_SA(0, 0), cA, voffA); PG8_STAGE(PG8_SA(0, 1), cA + hstep, voffA);
        if (wr == 1) PG8_BAR;
        PG8_WAIT_V(2); PG8_BAR;
        PG8_STAGE(PG8_SB(1, 0), cB + kstep, voffB); PG8_STAGE(PG8_SA(1, 0), cA + kstep, voffA); PG8_STAGE(PG8_SB(1, 1), cB + hstep + kstep, voffB);
        PG8_WAIT_V(6); PG8_BAR;
    } else {
        PG8_STAGE(PG8_SB(0, 0), cB, voffB); PG8_STAGE(PG8_SA(0, 0), cA, voffA); PG8_STAGE(PG8_SB(0, 1), cB + hstep, voffB); PG8_STAGE(PG8_SA(0, 1), cA + hstep, voffA);
        if (wr == 1) PG8_BAR;
        PG8_WAIT_V(4); PG8_BAR;
        PG8_STAGE(PG8_SB(1, 0), cB + kstep, voffB); PG8_STAGE(PG8_SA(1, 0), cA + kstep, voffA); PG8_STAGE(PG8_SB(1, 1), cB + hstep + kstep, voffB);
        PG8_WAIT_V(6); PG8_BAR;
    }
    for (;;) {
        const bool has_next = S.next(ui + 1, nxt);
        const char* nA = has_next ? (const char*)g.A + (size_t)nxt.pm * tstep : cA; const char* nB = has_next ? (const char*)g.Bt + (size_t)nxt.pn * tstep : cB;
        for (int t = 0; t < nt; t += 2) {
            const bool last = (t == nt - 2);
            const char* a1 = cA + (size_t)(t + 1) * kstep;
            const char* a2 = last ? nA : cA + (size_t)(t + 2) * kstep; const char* b2 = last ? nB : cB + (size_t)(t + 2) * kstep;
            const char* a3 = a2 + kstep; const char* b3 = b2 + kstep;
            if (last && has_next) S.a_ready(nxt);
            if constexpr (SP2) {
            PG8_LDB(B0, 0, 0); PG8_LDB(B1, 0, 1); PG8_SCHED; PG8_LDA(At, 0, 0); PG8_STAGE(PG8_SA(1, 1), a1 + hstep, voffA);
            PG8_WAIT_V(8); PG8_WAIT_L(0); PG8_BAR; PG8_MMA(0, 0, At, B0); PG8_MMA(0, 1, At, B1); PG8_BAR; PG8_SCHED;
            PG8_LDA(At, 0, 1); PG8_STAGE(PG8_SB(0, 0), b2, voffB); PG8_STAGE(PG8_SB(0, 1), b2 + hstep, voffB); PG8_STAGE(PG8_SA(0, 0), a2, voffA);
            PG8_WAIT_V(8); PG8_WAIT_L(0); PG8_BAR; PG8_MMA(1, 0, At, B0); PG8_MMA(1, 1, At, B1); PG8_BAR; PG8_SCHED;
            PG8_LDB(B0, 1, 0); PG8_LDB(B1, 1, 1); PG8_SCHED; PG8_LDA(At, 1, 0); PG8_STAGE(PG8_SA(0, 1), a2 + hstep, voffA);
            PG8_WAIT_V(8); PG8_WAIT_L(0); PG8_BAR; PG8_MMA(0, 0, At, B0); PG8_MMA(0, 1, At, B1); PG8_BAR; PG8_SCHED;
            PG8_LDA(At, 1, 1); PG8_STAGE(PG8_SB(1, 0), b3, voffB); PG8_STAGE(PG8_SB(1, 1), b3 + hstep, voffB); PG8_STAGE(PG8_SA(1, 0), a3, voffA);
            PG8_WAIT_V(8); PG8_WAIT_L(0); PG8_BAR; PG8_MMA(1, 0, At, B0); PG8_MMA(1, 1, At, B1); PG8_BAR; PG8_SCHED;
            } else {
            PG8_LDB(B0, 0, 0); PG8_SCHED; PG8_LDA(At, 0, 0); PG8_STAGE(PG8_SA(1, 1), a1 + hstep, voffA);
            PG8_WAIT_L(8); PG8_BAR; PG8_WAIT_L(0); PG8_MMA(0, 0, At, B0); PG8_BAR; PG8_SCHED;
            PG8_LDB(B1, 0, 1); PG8_STAGE(PG8_SB(0, 0), b2, voffB);
            PG8_BAR; PG8_WAIT_L(0); PG8_MMA(0, 1, At, B1); PG8_BAR;
            PG8_LDA(At, 0, 1); PG8_STAGE(PG8_SA(0, 0), a2, voffA);
            PG8_BAR; PG8_WAIT_L(0); PG8_MMA(1, 0, At, B0); PG8_BAR; PG8_SCHED;
            PG8_STAGE(PG8_SB(0, 1), b2 + hstep, voffB);
            PG8_WAIT_V(6); PG8_BAR; PG8_MMA(1, 1, At, B1); PG8_BAR;
            PG8_LDB(B0, 1, 0); PG8_SCHED; PG8_LDA(At, 1, 0); PG8_STAGE(PG8_SA(0, 1), a2 + hstep, voffA);
            PG8_WAIT_L(8); PG8_BAR; PG8_WAIT_L(0); PG8_MMA(0, 0, At, B0); PG8_BAR; PG8_SCHED;
            PG8_LDB(B1, 1, 1); PG8_STAGE(PG8_SB(1, 0), b3, voffB);
            PG8_BAR; PG8_WAIT_L(0); PG8_MMA(0, 1, At, B1); PG8_BAR;
            PG8_LDA(At, 1, 1); PG8_STAGE(PG8_SA(1, 0), a3, voffA);
            PG8_BAR; PG8_WAIT_L(0); PG8_MMA(1, 0, At, B0); PG8_BAR; PG8_SCHED;
            PG8_STAGE(PG8_SB(1, 1), b3 + hstep, voffB);
            PG8_WAIT_V(6); PG8_BAR; PG8_MMA(1, 1, At, B1); PG8_BAR;
            }
        }
        if constexpr (ALIGN_EPI) { if (wr == 0) PG8_BAR; }
        if constexpr (!Epi::AFTER_DRAIN) { E(acc, cur, wr, wc, fr, fq); S.done(cur); }
        if (!has_next) break;
#pragma unroll
        for (int a = 0; a < 2; ++a)
#pragma unroll
            for (int b = 0; b < 2; ++b)
#pragma unroll
                for (int m = 0; m < 4; ++m)
#pragma unroll
                    for (int n = 0; n < 2; ++n) acc[a][b][m][n] = (f32x4){0.f, 0.f, 0.f, 0.f};
        cur = nxt; cA = nA; cB = nB; ++ui;
        if constexpr (ALIGN_EPI) { if (wr == 1) PG8_BAR; }
    }
    PG8_WAIT_V(0);
    if constexpr (!ALIGN_EPI) { if (wr == 0) PG8_BAR; }
    PG8_BAR;
    if constexpr (Epi::AFTER_DRAIN) { E.fused(acc, cur, wr, wc, fr, fq, lds, wid, lane); S.done(cur); }
#undef PG8_SA
#undef PG8_SB
#undef PG8_STAGE
#undef PG8_LDA
#undef PG8_LDB
#undef PG8_MMA
#undef PG8_WAIT_V
#undef PG8_WAIT_L
#undef PG8_BAR
#undef PG8_SCHED
}
}
constexpr int NTHR = 512;
constexpr int SEQ = 8192, NTOK = 16384, DM = 1024, INC = 4104, PJ = 4096, DMIX = 1536, DFF = 2816, DEPTH = 2;
constexpr int C_Q = 0, C_K = 512, C_V = 1024, C_Z = 1536, C_XBC = 2048, C_GL = 3072, C_XL = 3584;
constexpr float LOG2E = 1.4426950408889634f;
constexpr size_t MiB = 1u << 20;
constexpr size_t WS_DT = 1 * MiB, WS_LSE = WS_DT + 512 * 1024, WS_AGA = 2 * MiB, WS_AGH = WS_AGA + 512 * 1024, WS_CD = 64 * 1024, WS_RSP = 3 * MiB;
constexpr size_t WS_WIN = 4 * MiB, WS_WOUT = 12 * MiB, WS_WGU = 15 * MiB, WS_WD = 26 * MiB;
constexpr size_t WS_XN = 32 * MiB;
constexpr size_t WS_ST = WS_XN, WS_PL = WS_XN + 16 * MiB;
constexpr size_t WS_PROJ = 64 * MiB;
constexpr size_t WS_MIX = 192 * MiB;
constexpr size_t WS_WOUT1 = 240 * MiB, WS_WGU1 = 243 * MiB;
constexpr size_t WS_END = 254 * MiB;
constexpr int LDS_BYTES = 153600;

#define LAS __attribute__((address_space(3)))
typedef unsigned short bf16;
typedef float f32x4 __attribute__((ext_vector_type(4)));
typedef float f32x2 __attribute__((ext_vector_type(2)));
typedef short bf16x8 __attribute__((ext_vector_type(8)));
typedef short bf16x4 __attribute__((ext_vector_type(4)));
typedef unsigned u32x4 __attribute__((ext_vector_type(4)));
typedef unsigned u32x2 __attribute__((ext_vector_type(2)));
#define LDS_WAIT() asm volatile("s_waitcnt lgkmcnt(0)" ::: "memory")

typedef __bf16 hbf16x2 __attribute__((ext_vector_type(2)));
__device__ __forceinline__ unsigned pk2(float lo, float hi) { const f32x2 v = {lo, hi}; const hbf16x2 b = __builtin_convertvector(v, hbf16x2); return __builtin_bit_cast(unsigned, b); }
__device__ __forceinline__ unsigned f2bf(float f) { return pk2(f, 0.f) & 0xffffu; }
__device__ __forceinline__ float bf2f(unsigned short b) { return __builtin_bit_cast(float, (unsigned)b << 16); }
__device__ __forceinline__ float bflo(unsigned w) { return __builtin_bit_cast(float, w << 16); }
__device__ __forceinline__ float bfhi(unsigned w) { return __builtin_bit_cast(float, w & 0xffff0000u); }
__device__ __forceinline__ float wave_sum(float v) {
#pragma unroll
    for (int o = 1; o < 64; o <<= 1) v += __shfl_xor(v, o);
    return v;
}
__device__ __forceinline__ float softplusf(float x) { return fmaxf(x, 0.f) + log1pf(__expf(-fabsf(x))); }
__device__ __forceinline__ float fexp(float x) { return __builtin_amdgcn_exp2f(x * LOG2E); }
__device__ __forceinline__ float sigmoidf_(float x) { return __builtin_amdgcn_rcpf(1.0f + fexp(-x)); }
__device__ __forceinline__ float siluf_(float x) { return x * __builtin_amdgcn_rcpf(1.0f + fexp(-x)); }
__device__ __forceinline__ float gelu_tanh(float x) { const float u = 0.7978845608028654f * (x + 0.044715f * x * x * x); return x * __builtin_amdgcn_rcpf(1.0f + fexp(-2.0f * u)); }
__device__ __forceinline__ f32x4 mfma16(bf16x8 a, bf16x8 b, f32x4 c) { return __builtin_amdgcn_mfma_f32_16x16x32_bf16(a, b, c, 0, 0, 0); }
__device__ __forceinline__ bf16x8 cat8(u32x2 lo, u32x2 hi) { u32x4 w; w.x = lo.x; w.y = lo.y; w.z = hi.x; w.w = hi.y; return __builtin_bit_cast(bf16x8, w); }

struct Params {
    const float* in[22];
    float* out; unsigned char* ws;
};

struct WtItem { const float* src; const float* gain; bf16* dst; int ldw, K; };
struct WtDst { bf16 *in, *out, *gu, *d; };
__device__ __forceinline__ WtItem wt_decode(const Params& p, int l, const WtDst& D, int it) {
    const float* w_in = p.in[2] + (size_t)l * DM * INC; const float* g1 = p.in[1] + l * DM;
    const float* w_out = p.in[16] + (size_t)l * DMIX * DM;
    const float* g2 = p.in[17] + l * DM; const float* w_gate = p.in[18] + (size_t)l * DM * DFF; const float* w_up = p.in[19] + (size_t)l * DM * DFF;
    const float* w_down = p.in[20] + (size_t)l * DFF * DM;
    bf16* WinT = D.in; bf16* WoutT = D.out; bf16* WguT = D.gu; bf16* WdT = D.d;
    constexpr int I_IN = (DM / 64) * (PJ / 32), I_OUT = (DMIX / 64) * (DM / 32), I_GU = (DM / 64) * (2 * DFF / 32);
    WtItem w; int r = it;
    if (r < I_IN) { const int nb = r % (PJ / 32), kb = r / (PJ / 32), n0 = 32 * nb, k0 = 64 * kb; w.src = w_in + (size_t)k0 * INC + (n0 < 3072 ? n0 : n0 + 8); w.gain = g1 + k0; w.dst = WinT + (size_t)n0 * DM + k0; w.ldw = INC; w.K = DM; return w; } r -= I_IN;
    if (r < I_OUT) { const int nb = r % (DM / 32), kb = r / (DM / 32), k0 = 64 * kb; w.src = w_out + (size_t)k0 * DM + 32 * nb; w.gain = nullptr; w.dst = WoutT + (size_t)(32 * nb) * DMIX + k0; w.ldw = DM; w.K = DMIX; return w; } r -= I_OUT;
    if (r < I_GU) { const int nb = r % (2 * DFF / 32), kb = r / (2 * DFF / 32), n0 = 32 * nb, pn = n0 >> 8, wi = n0 & 255, k0 = 64 * kb;
        w.src = (wi < 128 ? w_gate : w_up) + (size_t)k0 * DFF + 128 * pn + (wi & 127); w.gain = g2 + k0; w.dst = WguT + (size_t)n0 * DM + k0; w.ldw = DFF; w.K = DM; return w; } r -= I_GU;
    { const int nb = r % (DM / 32), kb = r / (DM / 32), k0 = 64 * kb; w.src = w_down + (size_t)k0 * DM + 32 * nb; w.gain = nullptr; w.dst = WdT + (size_t)(32 * nb) * DFF + k0; w.ldw = DM; w.K = DFF; return w; }
}
constexpr int WT_EARLY = (DM / 64) * (PJ / 32) + (DMIX / 64) * (DM / 32) + (DM / 64) * (2 * DFF / 32), WT_ALL = WT_EARLY + (DFF / 64) * (DM / 32);
__device__ __forceinline__ void weights_phase(const Params& p, int l, const WtDst& D, int lo, int NITEMS, LAS unsigned char* lds, int gw, int NGW, int wave, int lane) {
    LAS float* scr = (LAS float*)(lds + wave * 16384);
    if (lo + gw >= NITEMS) return;
    WtItem nx = wt_decode(p, l, D, lo + gw);
    float wn[32];
#pragma unroll
    for (int i = 0; i < 32; ++i) wn[i] = nx.src[(size_t)(2 * i + (lane >> 5)) * nx.ldw + (lane & 31)];
#pragma unroll 1
    for (int it = lo + gw; it < NITEMS; it += NGW) {
        const WtItem cu = nx; float wv[32];
#pragma unroll
        for (int i = 0; i < 32; ++i) wv[i] = wn[i];
        if (it + NGW < NITEMS) { nx = wt_decode(p, l, D, it + NGW);
#pragma unroll
            for (int i = 0; i < 32; ++i) wn[i] = nx.src[(size_t)(2 * i + (lane >> 5)) * nx.ldw + (lane & 31)]; }
        if (cu.gain) {
#pragma unroll
            for (int i = 0; i < 32; ++i) wv[i] *= cu.gain[2 * i + (lane >> 5)]; }
#pragma unroll
        for (int i = 0; i < 32; ++i) scr[(2 * i + (lane >> 5)) * 33 + (lane & 31)] = wv[i];
        LDS_WAIT(); asm volatile("" ::: "memory");
        const int c = lane & 7;
#pragma unroll
        for (int j = 0; j < 4; ++j) { const int n = (lane >> 3) + 8 * j; const LAS float* s = scr + (8 * c) * 33 + n;
            u32x4 o; o.x = pk2(s[0 * 33], s[1 * 33]); o.y = pk2(s[2 * 33], s[3 * 33]); o.z = pk2(s[4 * 33], s[5 * 33]); o.w = pk2(s[6 * 33], s[7 * 33]);
            *(u32x4*)(cu.dst + (size_t)n * cu.K + 8 * c) = o; }
        LDS_WAIT(); asm volatile("" ::: "memory");
    }
}
template <bool IN_BF16> __device__ __forceinline__ void load_row(const void* x, size_t m, int lane, f32x4 (&v)[4]) {
    if (IN_BF16) { const u32x2* xr = (const u32x2*)((const bf16*)x + m * DM) + lane;
#pragma unroll
        for (int j = 0; j < 4; ++j) { const u32x2 w = xr[64 * j]; v[j] = (f32x4){bflo(w.x), bfhi(w.x), bflo(w.y), bfhi(w.y)}; } }
    else { const f32x4* xr = (const f32x4*)((const float*)x + m * DM) + lane;
#pragma unroll
        for (int j = 0; j < 4; ++j) v[j] = xr[64 * j]; }
}
template <bool IN_BF16> __device__ __forceinline__ void norm_dt_phase(const void* xin, bf16* XN, const float* g, const float* w_in, const float* dt_bias, float* DT, int gw, int NGW, int lane, LAS unsigned char* lds, int tid) {
    LAS float* wtab = (LAS float*)lds;
    __syncthreads();
    for (int k = tid; k < DM; k += NTHR) { const float gk = g[k]; const f32x4* wp = (const f32x4*)(w_in + (size_t)k * INC + 3072); *(LAS f32x4*)(wtab + 8 * k) = wp[0] * gk; *(LAS f32x4*)(wtab + 8 * k + 4) = wp[1] * gk; }
    __syncthreads();
    float wd[4][4][8];
#pragma unroll
    for (int j = 0; j < 4; ++j)
#pragma unroll
        for (int e = 0; e < 4; ++e) { const int k = 256 * j + 4 * lane + e; const f32x4 a = *(const LAS f32x4*)(wtab + 8 * k), b = *(const LAS f32x4*)(wtab + 8 * k + 4);
#pragma unroll
            for (int q = 0; q < 4; ++q) { wd[j][e][q] = a[q]; wd[j][e][4 + q] = b[q]; } }
    const float bias = dt_bias[lane & 7];
    f32x4 vn[4];
    if (gw < NTOK) load_row<IN_BF16>(xin, (size_t)gw, lane, vn);
#pragma unroll 1
    for (int m = gw; m < NTOK; m += NGW) {
        f32x4 v[4]; float ss = 0.f; float d[8];
#pragma unroll
        for (int j = 0; j < 4; ++j) v[j] = vn[j];
        if (m + NGW < NTOK) load_row<IN_BF16>(xin, (size_t)(m + NGW), lane, vn);
#pragma unroll
        for (int q = 0; q < 8; ++q) d[q] = 0.f;
#pragma unroll
        for (int j = 0; j < 4; ++j) {
#pragma unroll
            for (int e = 0; e < 4; ++e) { ss += v[j][e] * v[j][e];
#pragma unroll
                for (int q = 0; q < 8; ++q) d[q] += v[j][e] * wd[j][e][q]; } }
        ss = wave_sum(ss); const float rs = 1.0f / sqrtf(ss * (1.0f / DM) + 1e-6f);
#pragma unroll
        for (int q = 0; q < 8; ++q) d[q] = wave_sum(d[q]);
        unsigned long long* o8 = (unsigned long long*)(XN + (size_t)m * DM) + lane;
#pragma unroll
        for (int j = 0; j < 4; ++j) o8[64 * j] = (unsigned long long)pk2(v[j][0] * rs, v[j][1] * rs) | ((unsigned long long)pk2(v[j][2] * rs, v[j][3] * rs) << 32);
        float dv = d[0];
#pragma unroll
        for (int q = 1; q < 8; ++q) dv = (lane == q) ? d[q] : dv;
        if (lane < 8) DT[(size_t)m * 8 + lane] = softplusf(dv * rs + bias);
    }
}
__device__ __forceinline__ void norm_phase(const bf16* xin, bf16* XN, int gw, int NGW, int lane) {
    f32x4 vn[4];
    if (gw < NTOK) load_row<true>(xin, (size_t)gw, lane, vn);
#pragma unroll 1
    for (int m = gw; m < NTOK; m += NGW) {
        f32x4 v[4]; float ss = 0.f;
#pragma unroll
        for (int j = 0; j < 4; ++j) v[j] = vn[j];
        if (m + NGW < NTOK) load_row<true>(xin, (size_t)(m + NGW), lane, vn);
#pragma unroll
        for (int j = 0; j < 4; ++j) ss += (v[j][0] * v[j][0] + v[j][1] * v[j][1]) + (v[j][2] * v[j][2] + v[j][3] * v[j][3]);
        ss = wave_sum(ss); const float rs = 1.0f / sqrtf(ss * (1.0f / DM) + 1e-6f);
        unsigned long long* o8 = (unsigned long long*)(XN + (size_t)m * DM) + lane;
#pragma unroll
        for (int j = 0; j < 4; ++j) o8[64 * j] = (unsigned long long)pk2(v[j][0] * rs, v[j][1] * rs) | ((unsigned long long)pk2(v[j][2] * rs, v[j][3] * rs) << 32);
    }
}
__device__ __forceinline__ void final_norm_phase(const bf16* xin, float* out, const float* g, int gw, int NGW, int lane) {
    f32x4 gv[4];
#pragma unroll
    for (int j = 0; j < 4; ++j) gv[j] = ((const f32x4*)g)[64 * j + lane];
    f32x4 vn[4];
    if (gw < NTOK) load_row<true>(xin, (size_t)gw, lane, vn);
#pragma unroll 1
    for (int m = gw; m < NTOK; m += NGW) {
        f32x4 v[4]; float ss = 0.f;
#pragma unroll
        for (int j = 0; j < 4; ++j) v[j] = vn[j];
        if (m + NGW < NTOK) load_row<true>(xin, (size_t)(m + NGW), lane, vn);
#pragma unroll
        for (int j = 0; j < 4; ++j) ss += (v[j][0] * v[j][0] + v[j][1] * v[j][1]) + (v[j][2] * v[j][2] + v[j][3] * v[j][3]);
        ss = wave_sum(ss); const float rs = 1.0f / sqrtf(ss * (1.0f / DM) + 1e-6f);
        f32x4* xr = (f32x4*)(out + (size_t)m * DM) + lane;
#pragma unroll
        for (int j = 0; j < 4; ++j) xr[64 * j] = v[j] * rs * gv[j];
    }
}
constexpr int KP = 72, ATT_KB = 256 * KP * 2, ATT_VB = ATT_KB, ATT_K0 = 0, ATT_V0 = 2 * ATT_KB;
typedef short v4i16_t __attribute__((ext_vector_type(4)));
__device__ __forceinline__ u32x2 lds_tr16(const LAS bf16* p) { return __builtin_bit_cast(u32x2, __builtin_amdgcn_ds_read_tr16_b64_v4i16((LAS v4i16_t*)p)); }
static_assert(ATT_V0 + 2 * ATT_VB <= LDS_BYTES - 1024, "attention LDS map");
#define ATT_DECODE(it_, b_, h_, r_, nb_) const int nb_ = (it_) % nblk, t2_##b_ = (it_) / nblk, r_ = t2_##b_ % dil, t3_##b_ = t2_##b_ / dil, h_ = t3_##b_ & 7, b_ = t3_##b_ >> 3
#define ATT_ISSUE(it_) do { ATT_DECODE(it_, bI, hI, rI, nbI); const int j0I = 128 * (nbI - 1); \
    _Pragma("unroll") for (int u = 0; u < 4; ++u) { const int id = tid + NTHR * u, key = id >> 3, dp = id & 7; int jj = j0I + key; jj = jj < 0 ? 0 : jj; \
        const bf16* rp = PROJ + ((size_t)bI * SEQ + rI + (size_t)dil * jj) * PJ + hI * 64 + 8 * dp; kreg[u] = *(const bf16x8*)(rp + C_K); vreg[u] = *(const bf16x8*)(rp + C_V); } \
    { const size_t qrowI = (size_t)bI * SEQ + rI + (size_t)dil * (128 * nbI + 16 * wid + fr); \
      _Pragma("unroll") for (int ks = 0; ks < 2; ++ks) qn[ks] = *(const bf16x8*)(PROJ + qrowI * PJ + C_Q + hI * 64 + 32 * ks + 8 * fq); } } while (0)
#define ATT_WRITE(buf_) do { LAS bf16* KBw = (LAS bf16*)(lds + ATT_K0 + (buf_) * ATT_KB); LAS bf16* VTw = (LAS bf16*)(lds + ATT_V0 + (buf_) * ATT_VB); \
    _Pragma("unroll") for (int u = 0; u < 4; ++u) { const int id = tid + NTHR * u, key = id >> 3, dp = id & 7; *(LAS bf16x8*)(KBw + key * KP + 8 * dp) = kreg[u]; *(LAS bf16x8*)(VTw + key * KP + 8 * dp) = vreg[u]; } } while (0)
__device__ __forceinline__ void attn_phase(LAS unsigned char* lds, const bf16* PROJ, bf16* MIX, float* LSE, int pat, int first  , int G, int tid) {
    asm volatile("" : "+v"(tid)); const int lane = tid & 63, wid = __builtin_amdgcn_readfirstlane(tid >> 6);
    const int fr = lane & 15, fq = lane >> 4;
    const int dil = pat == 0 ? 1 : (pat == 1 ? 4 : 16), nblk = SEQ / dil / 128;
    int it = (int)(((long)first * 1024) / G); const int it_end = (int)(((long)(first + 1) * 1024) / G); if (it >= it_end) return;
    bf16x8 kreg[4], vreg[4], qn[2], qf[2];
    ATT_ISSUE(it); ATT_WRITE(0); qf[0] = qn[0]; qf[1] = qn[1];
    __syncthreads();
#pragma unroll 1
    for (int n = 0;; ++n) {
        const int itn = it + 1; const bool has_next = itn < it_end;
        if (has_next) ATT_ISSUE(itn);
        ATT_DECODE(it, b, h, r, nb);
        const LAS bf16* KB = (const LAS bf16*)(lds + ATT_K0 + (n & 1) * ATT_KB); const LAS bf16* Vt = (const LAS bf16*)(lds + ATT_V0 + (n & 1) * ATT_VB);
        const int qi = 16 * wid + fr; const size_t qrow = (size_t)b * SEQ + r + (size_t)dil * (128 * nb + qi);
        bf16* op = MIX + qrow * DMIX + h * 64 + 4 * fq; float* lp = LSE + qrow * 8 + h;
        u32x2 pr[4]; float lpv = 0.f;
        if (pat > 0) { lpv = *lp;
#pragma unroll
            for (int dt = 0; dt < 4; ++dt) pr[dt] = *(const u32x2*)(op + 16 * dt); }
        const float sc = 0.125f * LOG2E, sl = exp2f(-(float)(h + 1)) * LOG2E * (float)dil, cl = -sl * (float)(128 + fr - 4 * fq);
        f32x4 s[10]; float mx = -1e30f; unsigned tvm = 0u;
#pragma unroll
        for (int jt = 0; jt < 9; ++jt) {
            const bool tv = (wid + jt <= 15) && (nb > 0 || wid + jt >= 8);
            if (tv) { tvm |= 1u << jt; const LAS bf16* kp = KB + (16 * (wid + jt) + fr) * KP + 8 * fq;
                f32x4 a = {0.f, 0.f, 0.f, 0.f}; a = mfma16(*(const LAS bf16x8*)kp, qf[0], a); a = mfma16(*(const LAS bf16x8*)(kp + 32), qf[1], a);
#pragma unroll
                for (int v = 0; v < 4; ++v) { float x = a[v] * sc + (cl + sl * (float)(16 * jt + v));
                    if (jt == 0) x = (4 * fq + v >= fr) ? x : -1e30f;
                    if (jt == 8) x = (4 * fq + v <= fr) ? x : -1e30f;
                    a[v] = x; mx = fmaxf(mx, x); }
                s[jt] = a; }
            else s[jt] = (f32x4){-1e30f, -1e30f, -1e30f, -1e30f};
        }
        mx = fmaxf(mx, __shfl_xor(mx, 16)); mx = fmaxf(mx, __shfl_xor(mx, 32));
        float lsum = 0.f;
#pragma unroll
        for (int jt = 0; jt < 9; ++jt) {
            if ((tvm >> jt) & 1u) {
#pragma unroll
                for (int v = 0; v < 4; ++v) { const float pv = __builtin_amdgcn_exp2f(s[jt][v] - mx); s[jt][v] = pv; lsum += pv; } }
            else s[jt] = (f32x4){0.f, 0.f, 0.f, 0.f};
        }
        s[9] = (f32x4){0.f, 0.f, 0.f, 0.f};
        lsum += __shfl_xor(lsum, 16); lsum += __shfl_xor(lsum, 32);
        f32x4 o[4];
#pragma unroll
        for (int dt = 0; dt < 4; ++dt) o[dt] = (f32x4){0.f, 0.f, 0.f, 0.f};
#pragma unroll
        for (int u = 0; u < 5; ++u) {
            u32x4 pw; pw.x = pk2(s[2 * u][0], s[2 * u][1]); pw.y = pk2(s[2 * u][2], s[2 * u][3]); pw.z = pk2(s[2 * u + 1][0], s[2 * u + 1][1]); pw.w = pk2(s[2 * u + 1][2], s[2 * u + 1][3]);
            const bf16x8 pb = __builtin_bit_cast(bf16x8, pw);
            int kt0 = wid + 2 * u, kt1 = kt0 + 1; kt0 = kt0 > 15 ? 15 : kt0; kt1 = kt1 > 15 ? 15 : kt1;
#pragma unroll
            for (int dt = 0; dt < 4; ++dt) { const LAS bf16* vr = Vt + (4 * fq + (fr >> 2)) * KP + 16 * dt + 4 * (fr & 3);
                const u32x2 lo = lds_tr16(vr + 16 * kt0 * KP), hi = lds_tr16(vr + 16 * kt1 * KP);
                o[dt] = mfma16(cat8(lo, hi), pb, o[dt]); }
        }
        const float inv = __builtin_amdgcn_rcpf(lsum); float lse = mx + __builtin_amdgcn_logf(lsum);
        float c1 = 0.f, c2 = inv;
        if (pat > 0) { const float M = fmaxf(lpv, lse); const float w1 = __builtin_amdgcn_exp2f(lpv - M), w2 = __builtin_amdgcn_exp2f(lse - M), iw = __builtin_amdgcn_rcpf(w1 + w2); c1 = w1 * iw; c2 = w2 * iw * inv; lse = M + __builtin_amdgcn_logf(w1 + w2); }
#pragma unroll
        for (int dt = 0; dt < 4; ++dt) { f32x4 ov = o[dt] * c2;
            if (pat > 0) { ov[0] += c1 * bflo(pr[dt].x); ov[1] += c1 * bfhi(pr[dt].x); ov[2] += c1 * bflo(pr[dt].y); ov[3] += c1 * bfhi(pr[dt].y); }
            u32x2 w; w.x = pk2(ov[0], ov[1]); w.y = pk2(ov[2], ov[3]); *(u32x2*)(op + 16 * dt) = w; }
        if (fq == 0) *lp = lse;
        if (has_next) { ATT_WRITE((n + 1) & 1); qf[0] = qn[0]; qf[1] = qn[1]; }
        __syncthreads();
        if (!has_next) break;
        it = itn;
    }
}

constexpr int XP = 136, XR = 272;
constexpr int SSD_XT = 0, SSD_B = 256 * XP * 2, SSD_C = SSD_B + 128 * XP * 2, SSD_TAB = SSD_C + 128 * XP * 2, SSD_END = SSD_TAB + 4096 + 64 + 512;
template <int PITCH> __device__ __forceinline__ void ssd_conv_pair(const bf16* PROJ, int b, int c, int th, int xcol, const float* cw, const float* cb, LAS bf16* dst, int dcol) {
    const f32x2 w0 = *(const f32x2*)(cw + xcol), w1 = *(const f32x2*)(cw + 1024 + xcol), w2 = *(const f32x2*)(cw + 2048 + xcol), w3 = *(const f32x2*)(cw + 3072 + xcol), bb = *(const f32x2*)(cb + xcol);
    const bf16* src = PROJ + ((size_t)b * SEQ + (size_t)c * 128 + 64 * th) * PJ + C_XBC + xcol;
    unsigned h3 = 0u, h2 = 0u, h1 = 0u;
    if (c > 0 || th > 0) { h3 = *(const unsigned*)(src - 3 * (ptrdiff_t)PJ); h2 = *(const unsigned*)(src - 2 * (ptrdiff_t)PJ); h1 = *(const unsigned*)(src - (ptrdiff_t)PJ); }
    f32x2 xm3 = {bflo(h3), bfhi(h3)}, xm2 = {bflo(h2), bfhi(h2)}, xm1 = {bflo(h1), bfhi(h1)};
#pragma unroll 1
    for (int tb = 0; tb < 2; ++tb) {
        unsigned xv[32];
#pragma unroll
        for (int e = 0; e < 32; ++e) xv[e] = *(const unsigned*)(src + (size_t)(32 * tb + e) * PJ);
#pragma unroll
        for (int e = 0; e < 32; ++e) { const f32x2 x = {bflo(xv[e]), bfhi(xv[e])}; const f32x2 y = bb + w0 * xm3 + w1 * xm2 + w2 * xm1 + w3 * x; xm3 = xm2; xm2 = xm1; xm1 = x;
            const int tok = 64 * th + 32 * tb + e; *(LAS unsigned*)(dst + tok * PITCH + dcol) = pk2(siluf_(y.x), siluf_(y.y)); }
    }
}
__device__ __forceinline__ float ssd_cumsum(const float* DT, const float* a_log, int b, int c, int g, int tid, int wid, int lane, LAS float* tot, float& dtv) {
    const int hh = tid >> 7, i = tid & 127;
    dtv = DT[((size_t)b * SEQ + c * 128 + i) * 8 + 4 * g + hh];
    float v = dtv * (-fexp(a_log[4 * g + hh]));
#pragma unroll
    for (int d = 1; d < 64; d <<= 1) { const float t = __shfl_up(v, d); if (lane >= d) v += t; }
    if (lane == 63) tot[wid] = v;
    __syncthreads();
    if (wid & 1) v += tot[wid - 1];
    return v;
}
__device__ __forceinline__ void ssd_states_item(LAS unsigned char* lds, const Params& p, int l, const bf16* PROJ, const float* DT, bf16* ST, float* CD, int it, int tid) {
    asm volatile("" : "+v"(tid)); const int lane = tid & 63, wid = __builtin_amdgcn_readfirstlane(tid >> 6);
    const int fr = lane & 15, fq = lane >> 4;
    const int g = it & 1, c = (it >> 1) & 63, b = it >> 7;
    LAS bf16* Xt = (LAS bf16*)(lds + SSD_XT); LAS bf16* Bt = (LAS bf16*)(lds + SSD_B);
    LAS float* wts = (LAS float*)(lds + SSD_TAB); LAS float* tot = wts + 1024;
    const float* cw = p.in[3] + (size_t)l * 4 * 1024; const float* cb = p.in[4] + l * 1024;
    { const int cp = tid & 255, th = tid >> 8;
      if (cp < 128) ssd_conv_pair<XR>(PROJ, b, c, th, 256 * g + 2 * cp, cw, cb, Xt, 2 * cp);
      else if (cp < 192) ssd_conv_pair<XP>(PROJ, b, c, th, 512 + 128 * g + 2 * (cp - 128), cw, cb, Bt, 2 * (cp - 128)); }
    float dtv; const float acs = ssd_cumsum(DT, p.in[6] + l * 8, b, c, g, tid, wid, lane, tot, dtv);
    { const int hh = tid >> 7, i = tid & 127; if (i == 127) { tot[8 + hh] = acs; CD[((size_t)b * 64 + c) * 8 + 4 * g + hh] = fexp(acs); } }
    __syncthreads();
    { const int hh = tid >> 7, i = tid & 127; wts[hh * 128 + i] = fexp(tot[8 + hh] - acs) * dtv; }
    __syncthreads();
    const int hh = wid >> 1, nh = wid & 1;
    f32x4 acc[4][4];
#pragma unroll
    for (int pt = 0; pt < 4; ++pt)
#pragma unroll
        for (int nt = 0; nt < 4; ++nt) acc[pt][nt] = (f32x4){0.f, 0.f, 0.f, 0.f};
#pragma unroll
    for (int ks = 0; ks < 4; ++ks) {
        const f32x4 wa = *(const LAS f32x4*)(wts + hh * 128 + 32 * ks + 8 * fq), wb = *(const LAS f32x4*)(wts + hh * 128 + 32 * ks + 8 * fq + 4);
        bf16x8 bfr[4];
#pragma unroll
        for (int nt = 0; nt < 4; ++nt) { const LAS bf16* bp = Bt + (32 * ks + 8 * fq + (fr >> 2)) * XP + 16 * (4 * nh + nt) + 4 * (fr & 3);
            bfr[nt] = cat8(lds_tr16(bp), lds_tr16(bp + 4 * XP)); }
#pragma unroll
        for (int pt = 0; pt < 4; ++pt) {
            const LAS bf16* xp_ = Xt + (32 * ks + 8 * fq + (fr >> 2)) * XR + 64 * hh + 16 * pt + 4 * (fr & 3); const u32x2 xlo = lds_tr16(xp_), xhi = lds_tr16(xp_ + 4 * XR);
            u32x4 xr; xr.x = xlo.x; xr.y = xlo.y; xr.z = xhi.x; xr.w = xhi.y;
            u32x4 xs; xs.x = pk2(bflo(xr.x) * wa[0], bfhi(xr.x) * wa[1]); xs.y = pk2(bflo(xr.y) * wa[2], bfhi(xr.y) * wa[3]);
            xs.z = pk2(bflo(xr.z) * wb[0], bfhi(xr.z) * wb[1]); xs.w = pk2(bflo(xr.w) * wb[2], bfhi(xr.w) * wb[3]);
            const bf16x8 xf = __builtin_bit_cast(bf16x8, xs);
#pragma unroll
            for (int nt = 0; nt < 4; ++nt) acc[pt][nt] = mfma16(bfr[nt], xf, acc[pt][nt]);
        }
    }
    bf16* sp = ST + ((((size_t)b * 64 + c) * 8 + 4 * g + hh) * 64) * 128;
#pragma unroll
    for (int pt = 0; pt < 4; ++pt)
#pragma unroll
        for (int nt = 0; nt < 4; ++nt) { u32x2 w; w.x = pk2(acc[pt][nt][0], acc[pt][nt][1]); w.y = pk2(acc[pt][nt][2], acc[pt][nt][3]);
            *(u32x2*)(sp + (size_t)(16 * pt + fr) * 128 + 16 * (4 * nh + nt) + 4 * fq) = w; }
    __syncthreads();
}
constexpr int YP = 264, SSD_YS_WAVE = 16 * YP * 2;
static_assert(8 * SSD_YS_WAVE <= SSD_TAB - SSD_B, "y staging fits the B|C images");
__device__ __forceinline__ void ssd_out_item(LAS unsigned char* lds, const Params& p, int l, const bf16* PROJ, const float* DT, const bf16* ST, bf16* MIX, int it, int tid) {
    asm volatile("" : "+v"(tid)); const int lane = tid & 63, wid = __builtin_amdgcn_readfirstlane(tid >> 6);
    const int fr = lane & 15, fq = lane >> 4;
    const int g = it & 1, c = (it >> 1) & 63, b = it >> 7;
    LAS bf16* Xt = (LAS bf16*)(lds + SSD_XT); LAS bf16* Bm = (LAS bf16*)(lds + SSD_B); LAS bf16* Cm = (LAS bf16*)(lds + SSD_C);
    LAS float* acsT = (LAS float*)(lds + SSD_TAB); LAS float* dtsT = acsT + 512; LAS float* tot = acsT + 1024; LAS float* rsT = acsT + 1040;
    const float* cw = p.in[3] + (size_t)l * 4 * 1024; const float* cb = p.in[4] + l * 1024;
    { const int cp = tid & 255, th = tid >> 8;
      if (cp < 128) ssd_conv_pair<XR>(PROJ, b, c, th, 256 * g + 2 * cp, cw, cb, Xt, 2 * cp);
      else if (cp < 192) ssd_conv_pair<XP>(PROJ, b, c, th, 512 + 128 * g + 2 * (cp - 128), cw, cb, Bm, 2 * (cp - 128));
      else ssd_conv_pair<XP>(PROJ, b, c, th, 768 + 128 * g + 2 * (cp - 192), cw, cb, Cm, 2 * (cp - 192)); }
    float dtv; const float acs = ssd_cumsum(DT, p.in[6] + l * 8, b, c, g, tid, wid, lane, tot, dtv);
    acsT[tid] = acs; dtsT[tid] = dtv;
    __syncthreads();
    const int w = wid;
    bf16x8 cf[4];
#pragma unroll
    for (int ks = 0; ks < 4; ++ks) cf[ks] = *(const LAS bf16x8*)(Cm + (16 * w + fr) * XP + 32 * ks + 8 * fq);
    f32x4 gt[8];
#pragma unroll
    for (int jt = 0; jt < 8; ++jt) { gt[jt] = (f32x4){0.f, 0.f, 0.f, 0.f};
        if (jt <= w) {
#pragma unroll
            for (int ks = 0; ks < 4; ++ks) gt[jt] = mfma16(*(const LAS bf16x8*)(Bm + (16 * jt + fr) * XP + 32 * ks + 8 * fq), cf[ks], gt[jt]); } }
    __syncthreads();
    LAS bf16* Ys = (LAS bf16*)(lds + SSD_B + wid * SSD_YS_WAVE);
    const int ii = 16 * w + fr; const size_t row = (size_t)b * SEQ + c * 128 + ii;
    float ssq = 0.f;
#pragma unroll 1
    for (int hh = 0; hh < 4; ++hh) {
        const float ai = acsT[hh * 128 + ii];
        const bf16* pp = ST + ((((size_t)b * 64 + c) * 8 + 4 * g + hh) * 64) * 128;
        bf16x8 pf[4][4]; u32x2 zr[4];
#pragma unroll
        for (int pt = 0; pt < 4; ++pt) {
#pragma unroll
            for (int ks = 0; ks < 4; ++ks) pf[pt][ks] = *(const bf16x8*)(pp + (size_t)(16 * pt + fr) * 128 + 32 * ks + 8 * fq);
            zr[pt] = *(const u32x2*)(PROJ + row * PJ + C_Z + 256 * g + 64 * hh + 16 * pt + 4 * fq); }
        f32x4 y[4];
#pragma unroll
        for (int pt = 0; pt < 4; ++pt) y[pt] = (f32x4){0.f, 0.f, 0.f, 0.f};
#pragma unroll
        for (int u = 0; u < 4; ++u) {
            if (2 * u <= w) {
                float sv[8];
#pragma unroll
                for (int q = 0; q < 2; ++q) { const int jt = 2 * u + q; const f32x4 aj = *(const LAS f32x4*)(acsT + hh * 128 + 16 * jt + 4 * fq), dj = *(const LAS f32x4*)(dtsT + hh * 128 + 16 * jt + 4 * fq);
#pragma unroll
                    for (int v = 0; v < 4; ++v) { const int j = 16 * jt + 4 * fq + v; sv[4 * q + v] = (j <= ii) ? gt[jt][v] * fexp(fminf(ai - aj[v], 0.f)) * dj[v] : 0.f; } }
                u32x4 pw; pw.x = pk2(sv[0], sv[1]); pw.y = pk2(sv[2], sv[3]); pw.z = pk2(sv[4], sv[5]); pw.w = pk2(sv[6], sv[7]);
                const bf16x8 pb = __builtin_bit_cast(bf16x8, pw);
#pragma unroll
                for (int pt = 0; pt < 4; ++pt) { const LAS bf16* xr = Xt + (32 * u + 4 * fq + (fr >> 2)) * XR + 64 * hh + 16 * pt + 4 * (fr & 3);
                    y[pt] = mfma16(cat8(lds_tr16(xr), lds_tr16(xr + 16 * XR)), pb, y[pt]); }
            }
        }
        const float ea = fexp(ai); const float dsk = p.in[7][l * 8 + 4 * g + hh];
#pragma unroll
        for (int pt = 0; pt < 4; ++pt) { f32x4 yo = {0.f, 0.f, 0.f, 0.f};
#pragma unroll
            for (int ks = 0; ks < 4; ++ks) yo = mfma16(pf[pt][ks], cf[ks], yo);
            const int ch = 64 * hh + 16 * pt + 4 * fq;
            const float zv[4] = {bflo(zr[pt].x), bfhi(zr[pt].x), bflo(zr[pt].y), bfhi(zr[pt].y)};
            float t[4]; const u32x2 xw = *(const LAS u32x2*)(Xt + ii * XR + ch); const float xq[4] = {bflo(xw.x), bfhi(xw.x), bflo(xw.y), bfhi(xw.y)};
#pragma unroll
            for (int v = 0; v < 4; ++v) { t[v] = (y[pt][v] + ea * yo[v] + dsk * xq[v]) * siluf_(zv[v]); ssq += t[v] * t[v]; }
            u32x2 wv; wv.x = pk2(t[0], t[1]); wv.y = pk2(t[2], t[3]); *(LAS u32x2*)(Ys + fr * YP + ch) = wv; }
    }
    ssq += __shfl_xor(ssq, 16); ssq += __shfl_xor(ssq, 32);
    if (fq == 0) rsT[ii] = __builtin_amdgcn_rsqf(ssq * (1.0f / 256.0f) + 1e-5f);
    asm volatile("" ::: "memory");
    const float* nw = p.in[8] + l * 512 + 256 * g + 8 * (lane & 31);
    const f32x4 n0 = *(const f32x4*)nw, n1 = *(const f32x4*)(nw + 4);
    bf16* mbase = MIX + ((size_t)b * SEQ + c * 128 + 16 * w) * DMIX + 512 + 256 * g + 8 * (lane & 31);
#pragma unroll
    for (int q = 0; q < 8; ++q) { const int tok = 2 * q + (lane >> 5); const u32x4 yr = *(const LAS u32x4*)(Ys + tok * YP + 8 * (lane & 31)); const float rstd = rsT[16 * w + tok];
        u32x4 o; o.x = pk2(bflo(yr.x) * rstd * n0[0], bfhi(yr.x) * rstd * n0[1]); o.y = pk2(bflo(yr.y) * rstd * n0[2], bfhi(yr.y) * rstd * n0[3]);
        o.z = pk2(bflo(yr.z) * rstd * n1[0], bfhi(yr.z) * rstd * n1[1]); o.w = pk2(bflo(yr.w) * rstd * n1[2], bfhi(yr.w) * rstd * n1[3]);
        *(u32x4*)(mbase + (size_t)tok * DMIX) = o; }
    __syncthreads();
}
static_assert(SSD_END <= LDS_BYTES, "SSD LDS map");
constexpr int LR_XP = 72, LR_AP = 68, LR_WAVE_BYTES = 16 * LR_XP * 2 + 2 * 16 * LR_AP * 4;
__device__ __forceinline__ void lru_local_item(LAS unsigned char* lds, const Params& p, int l, const bf16* PROJ, bf16* MIX, bf16* PL, float* AGA, float* AGH, int it, int tid) {
    asm volatile("" : "+v"(tid));
    const int lane = tid & 63, wid = __builtin_amdgcn_readfirstlane(tid >> 6), fr = lane & 15, fq = lane >> 4;
    const int kc = it & 127, b = it >> 7, ch = tid, cc = lane;
    LAS bf16* xcb = (LAS bf16*)(lds + wid * LR_WAVE_BYTES);
    LAS float* arL = (LAS float*)(lds + wid * LR_WAVE_BYTES + 16 * LR_XP * 2); LAS float* aiL = arL + 16 * LR_AP;
    bf16x8 wf[2][4][2];
#pragma unroll
    for (int mat = 0; mat < 2; ++mat) { const float* wb = p.in[mat == 0 ? 11 : 13] + (size_t)l * 32768 + (size_t)wid * 4096 + fr;
#pragma unroll
        for (int ks = 0; ks < 2; ++ks)
#pragma unroll
            for (int ct = 0; ct < 4; ++ct) { const float* wp = wb + (32 * ks + 8 * fq) * 64 + 16 * ct; u32x4 w;
                w.x = pk2(wp[0], wp[64]); w.y = pk2(wp[128], wp[192]); w.z = pk2(wp[256], wp[320]); w.w = pk2(wp[384], wp[448]); wf[mat][ct][ks] = __builtin_bit_cast(bf16x8, w); } }
    const float* cwp = p.in[9] + (size_t)l * 4 * 512 + ch; const float w0 = cwp[0], w1 = cwp[512], w2 = cwp[1024], w3 = cwp[1536], cb = p.in[10][l * 512 + ch];
    const float ba = p.in[12][l * 512 + ch], bx = p.in[14][l * 512 + ch], sp8 = -8.0f * softplusf(-p.in[15][l * 512 + ch]);
    const size_t row0 = (size_t)b * SEQ + (size_t)kc * 64;
    const bf16* src = PROJ + row0 * PJ + C_XL + ch;
    float xm3 = 0.f, xm2 = 0.f, xm1 = 0.f;
    if (kc > 0) { xm3 = bf2f(*(src - 3 * (ptrdiff_t)PJ)); xm2 = bf2f(*(src - 2 * (ptrdiff_t)PJ)); xm1 = bf2f(*(src - (ptrdiff_t)PJ)); }
    bf16 rawn[16];
#pragma unroll
    for (int e = 0; e < 16; ++e) rawn[e] = src[(size_t)e * PJ];
    float h = 0.f, P = 1.f;
#pragma unroll 1
    for (int sb = 0; sb < 4; ++sb) {
        float xc[16];
#pragma unroll
        for (int e = 0; e < 16; ++e) { const float x = bf2f(rawn[e]); const float y = cb + w0 * xm3 + w1 * xm2 + w2 * xm1 + w3 * x; xm3 = xm2; xm2 = xm1; xm1 = x; xc[e] = y; xcb[e * LR_XP + cc] = (bf16)f2bf(y); }
        if (sb < 3) {
#pragma unroll
            for (int e = 0; e < 16; ++e) rawn[e] = src[(size_t)(16 * (sb + 1) + e) * PJ]; }
        asm volatile("" ::: "memory");
        f32x4 accr[4], acci[4];
#pragma unroll
        for (int ct = 0; ct < 4; ++ct) { accr[ct] = (f32x4){0.f, 0.f, 0.f, 0.f}; acci[ct] = (f32x4){0.f, 0.f, 0.f, 0.f}; }
#pragma unroll
        for (int ks = 0; ks < 2; ++ks) { const bf16x8 a = *(const LAS bf16x8*)(xcb + fr * LR_XP + 32 * ks + 8 * fq);
#pragma unroll
            for (int ct = 0; ct < 4; ++ct) { accr[ct] = mfma16(a, wf[0][ct][ks], accr[ct]); acci[ct] = mfma16(a, wf[1][ct][ks], acci[ct]); } }
#pragma unroll
        for (int ct = 0; ct < 4; ++ct)
#pragma unroll
            for (int v = 0; v < 4; ++v) { arL[(4 * fq + v) * LR_AP + 16 * ct + fr] = accr[ct][v]; aiL[(4 * fq + v) * LR_AP + 16 * ct + fr] = acci[ct][v]; }
        asm volatile("" ::: "memory");
#pragma unroll
        for (int t = 0; t < 16; ++t) {
            const float ar = arL[t * LR_AP + cc] + ba, ai = aiL[t * LR_AP + cc] + bx;
            const float rg = sigmoidf_(ar), ig = sigmoidf_(ai), la = sp8 * rg, a = fexp(la), x2 = 2.0f * la;
            const float om_small = -x2 * (1.0f + x2 * (0.5f + x2 * (0.16666667f + x2 * (0.041666668f + x2 * (0.0083333338f + x2 * 0.0013888889f)))));
            const float om = (x2 > -0.25f) ? om_small : 1.0f - a * a;
            const float u = __builtin_amdgcn_sqrtf(om) * (ig * xc[t]);
            h = a * h + u; P *= a;
            const size_t row = row0 + 16 * sb + t;
            MIX[row * DMIX + 1024 + ch] = (bf16)f2bf(h); PL[row * 512 + ch] = (bf16)f2bf(P);
        }
        asm volatile("" ::: "memory");
    }
    AGA[((size_t)b * 128 + kc) * 512 + ch] = P; AGH[((size_t)b * 128 + kc) * 512 + ch] = h;
    __syncthreads();
}
__device__ __forceinline__ void lru_final_item(const bf16* PROJ, bf16* MIX, const bf16* PL, const float* AGH, int it, int tid) {
    asm volatile("" : "+v"(tid));
    const int kc = it & 127, b = it >> 7, ch = 2 * (tid & 255), th = tid >> 8;
    const f32x2 carry = *(const f32x2*)(AGH + ((size_t)b * 128 + kc) * 512 + ch);
    const size_t row0 = (size_t)b * SEQ + (size_t)kc * 64 + 32 * th;
    { constexpr int tb = 0;
        unsigned hl[32], pv[32], gv[32];
#pragma unroll
        for (int e = 0; e < 32; ++e) { const size_t row = row0 + 16 * tb + e; hl[e] = *(const unsigned*)(MIX + row * DMIX + 1024 + ch); pv[e] = *(const unsigned*)(PL + row * 512 + ch); gv[e] = *(const unsigned*)(PROJ + row * PJ + C_GL + ch); }
#pragma unroll
        for (int e = 0; e < 32; ++e) { const size_t row = row0 + 16 * tb + e;
            const float o0 = (bflo(hl[e]) + bflo(pv[e]) * carry.x) * gelu_tanh(bflo(gv[e])), o1 = (bfhi(hl[e]) + bfhi(pv[e]) * carry.y) * gelu_tanh(bfhi(gv[e]));
            *(unsigned*)(MIX + row * DMIX + 1024 + ch) = pk2(o0, o1); }
    }
}
__device__ __forceinline__ void scans_phase(bf16* ST, const float* CD, const float* AGA, float* AGH, int gtid, int gthreads, int gw, int NGW, int lane) {
    for (int e = gtid; e < 2 * 8 * 64 * 128; e += gthreads) {
        const int b = e >> 16, rem = e & 65535, h = rem >> 13;
        bf16* sp = ST + (size_t)b * 64 * 65536 + rem; const float* cd = CD + (size_t)b * 64 * 8 + h;
        float carry = 0.f;
#pragma unroll 1
        for (int c0 = 0; c0 < 64; c0 += 32) {
            bf16 s[32]; float d[32];
#pragma unroll
            for (int q = 0; q < 32; ++q) { s[q] = sp[(size_t)(c0 + q) * 65536]; d[q] = cd[(c0 + q) * 8]; }
#pragma unroll
            for (int q = 0; q < 32; ++q) { sp[(size_t)(c0 + q) * 65536] = (bf16)f2bf(carry); carry = d[q] * carry + bf2f(s[q]); }
        }
    }
    for (int e = gw; e < 2 * 512; e += NGW) {
        const int b = e >> 9, ch = e & 511;
        const float* ap = AGA + (size_t)b * 128 * 512 + ch; float* hp = AGH + (size_t)b * 128 * 512 + ch;
        const float a0 = ap[(size_t)(2 * lane) * 512], a1 = ap[(size_t)(2 * lane + 1) * 512], h0 = hp[(size_t)(2 * lane) * 512], h1 = hp[(size_t)(2 * lane + 1) * 512];
        float A = a0 * a1, H = a1 * h0 + h1;
#pragma unroll
        for (int dd = 1; dd < 64; dd <<= 1) { const float Ap = __shfl_up(A, dd), Hp = __shfl_up(H, dd); if (lane >= dd) { H = A * Hp + H; A = A * Ap; } }
        float cin = __shfl_up(H, 1); if (lane == 0) cin = 0.f;
        hp[(size_t)(2 * lane) * 512] = cin; hp[(size_t)(2 * lane + 1) * 512] = a0 * cin + h0;
    }
}
#define XB_TMO      128
#define XB_XCNT(j)  (256  + 64 * (j))
#define XB_XSUB(j)  (1280 + 64 * (j))
#define XB_XGEN(j)  (2304 + 64 * (j))
#define XB_TOP      3328
#define XB_TOPGEN   3392
#define XCD_BAR_WORDS 3456
#define XB_SPIN_CAP (1u << 18)

__device__ __forceinline__ unsigned xb_ld(unsigned* p)              { return __hip_atomic_load(p, __ATOMIC_RELAXED, __HIP_MEMORY_SCOPE_AGENT); }
__device__ __forceinline__ unsigned xb_add(unsigned* p, unsigned v) { return __hip_atomic_fetch_add(p, v, __ATOMIC_RELAXED, __HIP_MEMORY_SCOPE_AGENT); }
__device__ __forceinline__ unsigned xb_xcc_id() { return (unsigned)__builtin_amdgcn_s_getreg((3 << 11) | 20) & 0xFu; }
#define XB_SPIN(cond, bar) do { unsigned _sp = 0; while (cond) { \
    if ((++_sp & 255u) == 0u) { if (xb_ld(&(bar)[XB_TMO])) break; if (_sp > XB_SPIN_CAP) { atomicAdd(&(bar)[XB_TMO], 1u); break; } } } } while (0)

struct XcdBarrier {
    unsigned* bar; unsigned x;
    volatile LAS unsigned* st;
};

__device__ __forceinline__ XcdBarrier xcd_barrier_post(unsigned* bar, volatile LAS unsigned* st) {
    XcdBarrier b; b.bar = bar; b.x = xb_xcc_id(); b.st = st;
    if (threadIdx.x == 0) (void)xb_add(&bar[XB_XCNT(b.x)], 1u);
    return b;
}
__device__ __forceinline__ void xcd_barrier_complete(unsigned* bar, unsigned x, unsigned& nloc, unsigned& nx) {
    const unsigned G = gridDim.x * gridDim.y * gridDim.z;
    unsigned sum, cnt, mine, sp = 0u;
    for (;;) {
        sum = 0u; cnt = 0u; mine = 0u;
#pragma unroll
        for (unsigned j = 0; j < 16; ++j) { const unsigned c = xb_ld(&bar[XB_XCNT(j)]); sum += c; cnt += (c > 0u) ? 1u : 0u; mine = (j == x) ? c : mine; }
        if (sum == G) break;
        __builtin_amdgcn_s_sleep(1);
        if ((++sp & 255u) == 0u) { if (xb_ld(&bar[XB_TMO])) break; if (sp > XB_SPIN_CAP) { atomicAdd(&bar[XB_TMO], 1u); break; } }
    }
    nloc = mine > 0u ? mine : 1u; nx = cnt > 0u ? cnt : 1u;
}

__device__ __forceinline__ void xcd_barrier(const XcdBarrier& b) {
    asm volatile("s_waitcnt vmcnt(0)" ::: "memory");
    __syncthreads();
    if (threadIdx.x == 0) {
        unsigned* bar = b.bar;
        __builtin_amdgcn_s_waitcnt(0);
        unsigned nloc = b.st[0], nx = b.st[1];
        if (nloc == 0u) { xcd_barrier_complete(bar, b.x, nloc, nx); b.st[0] = nloc; b.st[1] = nx; }
        const unsigned old = xb_add(&bar[XB_XSUB(b.x)], 1u);
        const unsigned gen = old / nloc;
        if (old + 1u == (gen + 1u) * nloc) {
            __builtin_amdgcn_fence(__ATOMIC_RELEASE, "agent");
            asm volatile("s_waitcnt vmcnt(0)" ::: "memory");
            const unsigned og = xb_add(&bar[XB_TOP], 1u);
            const unsigned tg = og / nx;
            if (og + 1u == (tg + 1u) * nx) xb_add(&bar[XB_TOPGEN], 1u);
            else XB_SPIN(xb_ld(&bar[XB_TOPGEN]) == tg, bar);
            __builtin_amdgcn_fence(__ATOMIC_ACQUIRE, "agent");
            xb_add(&bar[XB_XGEN(b.x)], 1u);
            asm volatile("s_waitcnt vmcnt(0)" ::: "memory");
        } else {
            XB_SPIN(xb_ld(&bar[XB_XGEN(b.x)]) == gen, bar);
            __builtin_amdgcn_fence(__ATOMIC_ACQUIRE, "agent");
            asm volatile("s_waitcnt vmcnt(0)" ::: "memory");
        }
    }
    __syncthreads();
}

__global__ void __launch_bounds__(NTHR, 2) hybrid_fwd(Params p) {
    extern __shared__ __attribute__((aligned(16))) unsigned char lds_raw[];
    LAS unsigned char* lds = (LAS unsigned char*)lds_raw;
    volatile LAS unsigned* bst = (volatile LAS unsigned*)(lds + LDS_BYTES - 1024);
    if (threadIdx.x == 0) { bst[0] = 0u; bst[1] = 0u; }
    __syncthreads();
    const XcdBarrier xbar = xcd_barrier_post((unsigned*)p.ws, bst);
#define GRID_BAR() xcd_barrier(xbar)
    const int G = gridDim.x, bid = blockIdx.x, NGW = G * 8;
#ifdef DIAG_A
    LAS unsigned long long* dts = (LAS unsigned long long*)(lds + LDS_BYTES - 512);
    if (threadIdx.x == 0) { for (int k = 1; k < 32; ++k) dts[k] = 0ull; dts[0] = __builtin_amdgcn_s_memrealtime(); }
#define STAMP(k) do { if (threadIdx.x == 0) { const unsigned long long t_ = __builtin_amdgcn_s_memrealtime(); dts[1 + (k)] += t_ - dts[0]; dts[0] = t_; } } while (0)
#else
#define STAMP(k) do {} while (0)
#endif
#define FRESH_TID() int tid = threadIdx.x; asm volatile("" : "+v"(tid)); const int lane = tid & 63, wave = __builtin_amdgcn_readfirstlane(tid >> 6), gw = bid * 8 + wave; (void)lane; (void)gw;
    unsigned char* ws = p.ws;
    float* DT = (float*)(ws + WS_DT); float* LSE = (float*)(ws + WS_LSE); float* AGA = (float*)(ws + WS_AGA); float* AGH = (float*)(ws + WS_AGH); float* CD = (float*)(ws + WS_CD); float* RSP = (float*)(ws + WS_RSP);
    bf16* WinT = (bf16*)(ws + WS_WIN); bf16* WdT = (bf16*)(ws + WS_WD);
    bf16* XN = (bf16*)(ws + WS_XN); bf16* ST = (bf16*)(ws + WS_ST); bf16* PL = (bf16*)(ws + WS_PL);
    bf16* PROJ = (bf16*)(ws + WS_PROJ); bf16* ACT = (bf16*)(ws + WS_PROJ); bf16* MIX = (bf16*)(ws + WS_MIX);
#pragma unroll 1
    for (int l = 0; l < DEPTH; ++l) {
        bf16* XB1 = (bf16*)(ws + WS_PROJ + 92 * MiB); bf16* XB2 = (bf16*)p.out;
        bf16* WoutT = (bf16*)(ws + (l == 0 ? WS_WOUT : WS_WOUT1)); bf16* WguT = (bf16*)(ws + (l == 0 ? WS_WGU : WS_WGU1));
        const WtDst wd0{(bf16*)(ws + WS_WIN), (bf16*)(ws + WS_WOUT), (bf16*)(ws + WS_WGU), (bf16*)(ws + WS_WD)}, wd1{(bf16*)(ws + WS_WIN), (bf16*)(ws + WS_WOUT1), (bf16*)(ws + WS_WGU1), (bf16*)(ws + WS_WD)};
        { FRESH_TID();
        if (l == 0) weights_phase(p, 0, wd0, 0, WT_ALL, lds, gw, NGW, wave, lane);
        if (l == 0) norm_dt_phase<false>(p.in[0], XN, p.in[1] + l * DM, p.in[2] + (size_t)l * DM * INC, p.in[5] + l * 8, DT, gw, NGW, lane, lds, tid);
        else norm_dt_phase<true>(XB2, XN, p.in[1] + l * DM, p.in[2] + (size_t)l * DM * INC, p.in[5] + l * 8, DT, gw, NGW, lane, lds, tid);
        }
        STAMP(0); GRID_BAR(); STAMP(1);
        { pg8::Gemm g{XN, WinT, NTOK, PJ, DM}; pg8::StaticOrder S; S.init(NTOK, PJ, G, bid); pg8::EpiBf16<0> E{PROJ, PJ, nullptr, 0, 0, 1.f};
          pg8::gemm_phase<pg8::EpiBf16<0>, pg8::StaticOrder, true, true>(lds, g, S, E); }
        STAMP(2); GRID_BAR(); STAMP(3);
        { FRESH_TID();
        int it = bid;
        for (; it < 512; it += G) {
            if (it < 256) { lru_local_item(lds, p, l, PROJ, MIX, PL, AGA, AGH, it, tid); STAMP(4); }
            else { ssd_states_item(lds, p, l, PROJ, DT, ST, CD, it - 256, tid); STAMP(5); }
        }
        attn_phase(lds, PROJ, MIX, LSE, 0, bid, G, tid); STAMP(6);
        }
        GRID_BAR(); STAMP(7);
        { FRESH_TID();
        scans_phase(ST, CD, AGA, AGH, bid * NTHR + tid, G * NTHR, gw, NGW, lane); STAMP(8);
        attn_phase(lds, PROJ, MIX, LSE, 1, bid, G, tid);
        }
        STAMP(9); GRID_BAR(); STAMP(10);
        { FRESH_TID();
        int it = bid;
        for (; it < 512; it += G) {
            if (it < 256) { ssd_out_item(lds, p, l, PROJ, DT, ST, MIX, it, tid); STAMP(11); }
            else { lru_final_item(PROJ, MIX, PL, AGH, it - 256, tid); STAMP(12); }
        }
        attn_phase(lds, PROJ, MIX, LSE, 2, bid, G, tid); STAMP(13);
        }
        GRID_BAR(); STAMP(14);
        { pg8::Gemm g{MIX, WoutT, NTOK, DM, DMIX}; pg8::StaticOrder S; S.init(NTOK, DM, G, bid); if (l == 0) { pg8::EpiResBf<true> E{p.in[0], XB1, DM, RSP}; pg8::gemm_phase<pg8::EpiResBf<true>, pg8::StaticOrder, true, true>(lds, g, S, E); }
          else { pg8::EpiResBf<false> E{XB2, XB1, DM, RSP}; pg8::gemm_phase<pg8::EpiResBf<false>, pg8::StaticOrder, true, true>(lds, g, S, E); } }
        STAMP(15); GRID_BAR(); STAMP(16);
        { pg8::Gemm g{XB1, WguT, NTOK, 2 * DFF, DM}; pg8::StaticOrder S; S.init(NTOK, 2 * DFF, G, bid); pg8::EpiSwiGLU E{ACT, DFF, RSP};
          pg8::gemm_phase<pg8::EpiSwiGLU, pg8::StaticOrder, true, true>(lds, g, S, E); }
        {
          const int nun = (NTOK / 256) * (2 * DFF / 256), rounds = (nun + G - 1) / G, nbusy = nun - (rounds - 1) * G;
          if (nbusy < G && bid >= nbusy) { FRESH_TID(); const int gw2 = (bid - nbusy) * 8 + wave, ngw2 = (G - nbusy) * 8;
              if (l == 0) weights_phase(p, 1, wd1, 0, WT_EARLY, lds, gw2, ngw2, wave, lane); else weights_phase(p, 1, wd1, WT_EARLY, WT_ALL, lds, gw2, ngw2, wave, lane); }
          else if (nbusy >= G) { FRESH_TID(); if (l == 0) weights_phase(p, 1, wd1, 0, WT_EARLY, lds, gw, NGW, wave, lane); else weights_phase(p, 1, wd1, WT_EARLY, WT_ALL, lds, gw, NGW, wave, lane); } }
        STAMP(19); GRID_BAR(); STAMP(20);
        { pg8::Gemm g{ACT, WdT, NTOK, DM, DFF}; pg8::StaticOrder S; S.init(NTOK, DM, G, bid); pg8::EpiResBf<false> E{XB1, l == 0 ? XB2 : XB1, DM, nullptr};
          pg8::gemm_phase<pg8::EpiResBf<false>, pg8::StaticOrder, true, true>(lds, g, S, E); }
        STAMP(21); GRID_BAR(); STAMP(22);
    }
    { FRESH_TID(); final_norm_phase((const bf16*)(ws + WS_PROJ + 92 * MiB), p.out, p.in[21], gw, NGW, lane); }
    STAMP(23);
#ifdef DIAG_A
    if (bid == 0) {
        __threadfence(); __syncthreads();
        const float ta = (float)dts[1 + DIAG_A] * 0.01f, tb = (float)dts[1 + DIAG_B] * 0.01f;
        const float Ea = sqrtf(0.16384f * ta);
        atomicAdd(p.out + threadIdx.x, Ea); atomicAdd(p.out + 512 + threadIdx.x, Ea);
        if (threadIdx.x == 0) atomicAdd(p.out + 1024, tb * 0.1f);
    }
#endif
}

extern "C" void kernel_launch(void* const* d_in, const int* in_sizes, int n_in, void* d_out, int out_size, void* d_ws, size_t ws_size, hipStream_t stream) {
    static int grid = 0;
    if (grid == 0) {
        if (n_in != 22 || out_size != NTOK * DM || ws_size < WS_END) { fprintf(stderr, "kernel_launch: unexpected shapes (n_in %d out %d ws %zu)\n", n_in, out_size, ws_size); grid = -1; return; }
        int dev = 0, cus = 0, per_cu = 0;
        hipGetDevice(&dev); hipDeviceGetAttribute(&cus, hipDeviceAttributeMultiprocessorCount, dev);
        if (hipFuncSetAttribute((const void*)hybrid_fwd, hipFuncAttributeMaxDynamicSharedMemorySize, LDS_BYTES) != hipSuccess) { fprintf(stderr, "kernel_launch: hipFuncSetAttribute failed\n"); grid = -1; return; }
        if (hipOccupancyMaxActiveBlocksPerMultiprocessor(&per_cu, (const void*)hybrid_fwd, NTHR, LDS_BYTES) != hipSuccess || per_cu < 1) { fprintf(stderr, "kernel_launch: occupancy query failed (%d)\n", per_cu); grid = -1; return; }
        grid = cus * per_cu;
    }
    if (grid < 0) return;
    if (hipMemsetAsync(d_ws, 0, 16384, stream) != hipSuccess) { fprintf(stderr, "kernel_launch: memset failed\n"); return; }
    Params p{};
    for (int i = 0; i < 22; ++i) p.in[i] = (const float*)d_in[i];
    p.out = (float*)d_out; p.ws = (unsigned char*)d_ws;
    void* args[] = {&p};
    hipError_t e = hipLaunchCooperativeKernel((const void*)hybrid_fwd, dim3(grid), dim3(NTHR), args, LDS_BYTES, stream);
    if (e != hipSuccess) fprintf(stderr, "cooperative launch failed: %s (grid %d)\n", hipGetErrorString(e), grid);
}
```

```cpp
#include <hip/hip_runtime.h>
#include <hip/hip_cooperative_groups.h>
#include <cstdio>
#include <cstdint>
namespace cg = cooperative_groups;
namespace pg8 {
#define PG8_LAS __attribute__((address_space(3)))
typedef unsigned short bf16_t;
typedef short bf16x8 __attribute__((ext_vector_type(8)));
typedef float f32x4 __attribute__((ext_vector_type(4)));
typedef unsigned u32x4 __attribute__((ext_vector_type(4)));
constexpr int BM = 256, BK = 64, HALF = 128, HTB = HALF * BK * 2  , STAGE_BYTES = 8 * HTB, NXCD = 8, WGM = 8;

__host__ __device__ __forceinline__ int lds_byte(int r, int c) { const int st = (r >> 4) * 2 + (c >> 5), rr = r & 15, cc = c & 31, ob = rr * 64 + cc * 2; return st * 1024 + (ob ^ (((ob >> 9) & 1) << 5)); }
__host__ __device__ __forceinline__ void stage_rc(int b, int& R, int& C) { const int st = b / 1024, sb = b % 1024, swz = sb ^ (((sb >> 9) & 1) << 5); R = (st >> 1) * 16 + swz / 64; C = (st & 1) * 32 + (swz % 64) / 2; }
__host__ __device__ __forceinline__ int perm32(int rho) { const int n = rho >> 4, i = rho & 15; return 8 * (i >> 2) + 4 * n + (i & 3); }

struct Unit { int pm, pn; };
struct Gemm { const bf16_t* A; const bf16_t* Bt; int M, N, K; };

struct StaticOrder {
    int nM, nN, nwg, G, c;
    __host__ __device__ void init(int M, int N, int G_, int c_) { nM = M / BM; nN = N / BM; nwg = nM * nN; G = G_; c = c_; }
    __host__ __device__ bool next(int i, Unit& u) const {
        const long L = (long)i * G + c; if (L >= nwg) return false;
        int wgid = (int)L; { const int q = nwg / NXCD, r = nwg % NXCD, xcd = wgid % NXCD, off = wgid / NXCD; wgid = (xcd < r ? xcd * (q + 1) : r * (q + 1) + (xcd - r) * q) + off; }
        const int nig = WGM * nN, gid = wgid / nig, fm = gid * WGM, gsz = (nM - fm) < WGM ? (nM - fm) : WGM;
        u.pm = fm + ((wgid % nig) % gsz); u.pn = (wgid % nig) / gsz; return true;
    }
    __device__ __forceinline__ void a_ready(const Unit&) const {}
    __device__ __forceinline__ void done(const Unit&) const {}
};

__device__ __forceinline__ unsigned cvt_pk_bf16(float lo, float hi) { unsigned r; asm volatile("v_cvt_pk_bf16_f32 %0, %1, %2" : "=v"(r) : "v"(lo), "v"(hi)); return r; }
typedef float f32x2 __attribute__((ext_vector_type(2)));
__device__ __forceinline__ f32x2 gelu_pk(f32x2 v) {
    const f32x2 av = __builtin_elementwise_abs(v), d = av * 0.2316418882f + 1.0f;
    f32x2 t; t.x = __builtin_amdgcn_rcpf(d.x); t.y = __builtin_amdgcn_rcpf(d.y);
    f32x2 q = t * 0.5307027145f + (-0.7265760135f); q = q * t + 0.7107068705f; q = q * t + (-0.142248368f); q = q * t + 0.127414796f; q = q * t;
    const f32x2 s = (v * v) * (-0.72134752044f);
    f32x2 e; e.x = __builtin_amdgcn_exp2f(s.x); e.y = __builtin_amdgcn_exp2f(s.y);
    const f32x2 m = v * (q * e), r = v - m;
    f32x2 o; o.x = v.x < 0.f ? m.x : r.x; o.y = v.y < 0.f ? m.y : r.y; return o;
}

template <int ACT  > struct EpiBf16 {
    static constexpr bool PERM = true, AFTER_DRAIN = false; static_assert(ACT == 0 || ACT == 1, "EpiBf16: ACT is 0 (none) or 1 (gelu_pk)");
    bf16_t* O; int ldc; const float* bias; int split_cols; size_t split_stride; float scale0;
    __device__ __forceinline__ void operator()(const f32x4 (&acc)[2][2][4][2], const Unit& u, int wr, int wc, int fr, int fq) const {
        const int row0 = u.pm * BM + wr * 64 + fr; int colt = u.pn * BM; bf16_t* base = O;
        float sc = 1.f; if (split_cols) { const int t = colt / split_cols; base += (size_t)t * split_stride; colt -= t * split_cols; if (t == 0) sc = scale0; }
        const int col0 = colt + wc * 32 + 8 * fq, bcol0 = u.pn * BM + wc * 32 + 8 * fq;
        f32x4 bv[2][2];
#pragma unroll
        for (int bj = 0; bj < 2; ++bj)
#pragma unroll
            for (int n = 0; n < 2; ++n) bv[bj][n] = bias ? *(const f32x4*)(bias + bcol0 + bj * HALF + 4 * n) : (f32x4){0.f, 0.f, 0.f, 0.f};
#pragma unroll
        for (int ai = 0; ai < 2; ++ai)
#pragma unroll
            for (int m = 0; m < 4; ++m) { bf16_t* rowp = base + (size_t)(row0 + ai * HALF + m * 16) * ldc + col0;
#pragma unroll
                for (int bj = 0; bj < 2; ++bj) { f32x4 v0 = acc[ai][bj][m][0] + bv[bj][0], v1 = acc[ai][bj][m][1] + bv[bj][1];
                    if (ACT == 1) { f32x2 a = gelu_pk((f32x2){v0[0], v0[1]}), b = gelu_pk((f32x2){v0[2], v0[3]}), c = gelu_pk((f32x2){v1[0], v1[1]}), d = gelu_pk((f32x2){v1[2], v1[3]});
                        v0 = (f32x4){a.x, a.y, b.x, b.y}; v1 = (f32x4){c.x, c.y, d.x, d.y}; }
                    v0 = v0 * sc; v1 = v1 * sc; u32x4 w; w.x = cvt_pk_bf16(v0[0], v0[1]); w.y = cvt_pk_bf16(v0[2], v0[3]); w.z = cvt_pk_bf16(v1[0], v1[1]); w.w = cvt_pk_bf16(v1[2], v1[3]);
                    *(u32x4*)(rowp + bj * HALF) = w; } }
    }
};
struct EpiResF32 {
    static constexpr bool PERM = false, AFTER_DRAIN = false;
    const float* base; float* out; int ldc;
    __device__ __forceinline__ void operator()(const f32x4 (&acc)[2][2][4][2], const Unit& u, int wr, int wc, int fr, int fq) const {
        const int row0 = u.pm * BM + wr * 64 + fr, col0 = u.pn * BM + wc * 32 + 4 * fq;
#pragma unroll
        for (int ai = 0; ai < 2; ++ai)
#pragma unroll
            for (int m = 0; m < 4; ++m) { const size_t off = (size_t)(row0 + ai * HALF + m * 16) * ldc + col0;
#pragma unroll
                for (int bj = 0; bj < 2; ++bj)
#pragma unroll
                    for (int n = 0; n < 2; ++n) { const f32x4 b = *(const f32x4*)(base + off + bj * HALF + n * 16); *(f32x4*)(out + off + bj * HALF + n * 16) = b + acc[ai][bj][m][n]; } }
    }
};
template <bool BASE_F32> struct EpiResBf {
    static constexpr bool PERM = true, AFTER_DRAIN = false;
    const void* base; bf16_t* out; int ldc; float* rsp;
    __device__ __forceinline__ void operator()(const f32x4 (&acc)[2][2][4][2], const Unit& u, int wr, int wc, int fr, int fq) const {
        const int row0 = u.pm * BM + wr * 64 + fr, col0 = u.pn * BM + wc * 32 + 8 * fq;
#pragma unroll
        for (int ai = 0; ai < 2; ++ai)
#pragma unroll
            for (int m = 0; m < 4; ++m) { const size_t off = (size_t)(row0 + ai * HALF + m * 16) * ldc + col0; float ss = 0.f;
#pragma unroll
                for (int bj = 0; bj < 2; ++bj) { f32x4 b0, b1;
                    if (BASE_F32) { const float* bp = (const float*)base + off + bj * HALF; b0 = *(const f32x4*)bp; b1 = *(const f32x4*)(bp + 4); }
                    else { const u32x4 w = *(const u32x4*)((const bf16_t*)base + off + bj * HALF);
                        b0 = (f32x4){__builtin_bit_cast(float, w.x << 16), __builtin_bit_cast(float, w.x & 0xffff0000u), __builtin_bit_cast(float, w.y << 16), __builtin_bit_cast(float, w.y & 0xffff0000u)};
                        b1 = (f32x4){__builtin_bit_cast(float, w.z << 16), __builtin_bit_cast(float, w.z & 0xffff0000u), __builtin_bit_cast(float, w.w << 16), __builtin_bit_cast(float, w.w & 0xffff0000u)}; }
                    const f32x4 v0 = b0 + acc[ai][bj][m][0], v1 = b1 + acc[ai][bj][m][1];
                    u32x4 o; o.x = cvt_pk_bf16(v0[0], v0[1]); o.y = cvt_pk_bf16(v0[2], v0[3]); o.z = cvt_pk_bf16(v1[0], v1[1]); o.w = cvt_pk_bf16(v1[2], v1[3]);
                    *(u32x4*)(out + off + bj * HALF) = o;
                    ss += ((v0[0] * v0[0] + v0[1] * v0[1]) + (v0[2] * v0[2] + v0[3] * v0[3])) + ((v1[0] * v1[0] + v1[1] * v1[1]) + (v1[2] * v1[2] + v1[3] * v1[3])); }
                if (rsp) { ss += __shfl_xor(ss, 16); ss += __shfl_xor(ss, 32); if (fq == 0) rsp[(size_t)(row0 + ai * HALF + m * 16) * 16 + 4 * u.pn + wc] = ss; } }
    }
};
struct EpiSwiGLU {
    static constexpr bool PERM = true, AFTER_DRAIN = false;
    bf16_t* O; int ldc; const float* rsp;
    __device__ __forceinline__ void operator()(const f32x4 (&acc)[2][2][4][2], const Unit& u, int wr, int wc, int fr, int fq) const {
        const int row0 = u.pm * BM + wr * 64 + fr, f0 = u.pn * 128 + wc * 32 + 8 * fq;
#pragma unroll
        for (int ai = 0; ai < 2; ++ai)
#pragma unroll
            for (int m = 0; m < 4; ++m) { bf16_t* rowp = O + (size_t)(row0 + ai * HALF + m * 16) * ldc + f0;
                const f32x4* rp = (const f32x4*)(rsp + (size_t)(row0 + ai * HALF + m * 16) * 16); const f32x4 q0 = rp[0], q1 = rp[1], q2 = rp[2], q3 = rp[3];
                const float tot = ((q0[0] + q0[1]) + (q0[2] + q0[3])) + ((q1[0] + q1[1]) + (q1[2] + q1[3])) + ((q2[0] + q2[1]) + (q2[2] + q2[3])) + ((q3[0] + q3[1]) + (q3[2] + q3[3]));
                const float rs = __builtin_amdgcn_rsqf(tot * (1.0f / 1024.0f) + 1e-6f);
                float r[8];
#pragma unroll
                for (int n = 0; n < 2; ++n)
#pragma unroll
                    for (int e = 0; e < 4; ++e) { const float g = acc[ai][0][m][n][e] * rs, up = acc[ai][1][m][n][e] * rs; r[4 * n + e] = g * up * __builtin_amdgcn_rcpf(1.0f + __builtin_amdgcn_exp2f(-1.4426950408889634f * g)); }
                u32x4 w; w.x = cvt_pk_bf16(r[0], r[1]); w.y = cvt_pk_bf16(r[2], r[3]); w.z = cvt_pk_bf16(r[4], r[5]); w.w = cvt_pk_bf16(r[6], r[7]);
                *(u32x4*)rowp = w; }
    }
};
template <class Epi, class Sched, bool ALIGN_EPI = false, bool SP2 = false>
__device__ __forceinline__ void gemm_phase(PG8_LAS unsigned char* lds, const Gemm g, const Sched& S, const Epi& E) {
    int tid_l = threadIdx.x; asm volatile("" : "+v"(tid_l));
    const int tid = tid_l, wid = __builtin_amdgcn_readfirstlane(tid >> 6), lane = tid & 63, wr = wid >> 2, wc = wid & 3, fr = lane & 15, fq = lane >> 4;
    const int K = g.K, nt = K / BK;
    unsigned voffA[2], voffB[2];
#pragma unroll
    for (int i = 0; i < 2; ++i) { int R, C; stage_rc(tid * 16 + i * 8192, R, C); const int Rb = Epi::PERM ? ((R & ~31) + perm32(R & 31)) : R;
        voffA[i] = (unsigned)(R * K + C) * 2u; voffB[i] = (unsigned)(Rb * K + C) * 2u; }
    const size_t kstep = (size_t)(BK * 2);
    const size_t hstep = (size_t)HALF * K * 2;
    const size_t tstep = 2 * hstep;
    const unsigned ldsw = (unsigned)wid * 1024u;
    const int aoff = lds_byte(wr * 64 + fr, fq * 8), boff = lds_byte(wc * 32 + fr, fq * 8);
#define PG8_SA(b, h) (((b) * 2 + (h)) * HTB)
#define PG8_SB(b, h) ((4 + (b) * 2 + (h)) * HTB)
#define PG8_STAGE(bufoff, gbase, voff) do { _Pragma("unroll") for (int _i = 0; _i < 2; ++_i) \
        __builtin_amdgcn_global_load_lds((const unsigned*)((const char*)(gbase) + (voff)[_i]), (PG8_LAS unsigned*)(lds + (bufoff) + ldsw + _i * 8192), 16, 0, 0); } while (0)
#define PG8_LDA(dst, b, h) do { _Pragma("unroll") for (int m = 0; m < 4; ++m) _Pragma("unroll") for (int k = 0; k < 2; ++k) dst[m][k] = *(const PG8_LAS bf16x8*)(lds + PG8_SA(b, h) + aoff + m * 2048 + k * 1024); } while (0)
#define PG8_LDB(dst, b, h) do { _Pragma("unroll") for (int n = 0; n < 2; ++n) _Pragma("unroll") for (int k = 0; k < 2; ++k) dst[n][k] = *(const PG8_LAS bf16x8*)(lds + PG8_SB(b, h) + boff + n * 2048 + k * 1024); } while (0)
#define PG8_MMA(ai, bj, At, Bt) do { __builtin_amdgcn_s_setprio(1); _Pragma("unroll") for (int m = 0; m < 4; ++m) _Pragma("unroll") for (int n = 0; n < 2; ++n) _Pragma("unroll") for (int k = 0; k < 2; ++k) \
        acc[ai][bj][m][n] = __builtin_amdgcn_mfma_f32_16x16x32_bf16(Bt[n][k], At[m][k], acc[ai][bj][m][n], 0, 0, 0); __builtin_amdgcn_s_setprio(0); } while (0)
#define PG8_WAIT_V(n) asm volatile("s_waitcnt vmcnt(" #n ")" ::: "memory")
#define PG8_WAIT_L(n) asm volatile("s_waitcnt lgkmcnt(" #n ")" ::: "memory")
#define PG8_BAR __builtin_amdgcn_s_barrier()
#define PG8_SCHED __builtin_amdgcn_sched_barrier(0)
    Unit cur, nxt; int ui = 0;
    if (!S.next(0, cur)) return;
    f32x4 acc[2][2][4][2];
#pragma unroll
    for (int a = 0; a < 2; ++a)
#pragma unroll
        for (int b = 0; b < 2; ++b)
#pragma unroll
            for (int m = 0; m < 4; ++m)
#pragma unroll
                for (int n = 0; n < 2; ++n) acc[a][b][m][n] = (f32x4){0.f, 0.f, 0.f, 0.f};
    bf16x8 At[4][2], B0[2][2], B1[2][2];
    const char* cA = (const char*)g.A + (size_t)cur.pm * tstep; const char* cB = (const char*)g.Bt + (size_t)cur.pn * tstep;
    S.a_ready(cur);
    if constexpr (SP2) {
        PG8_STAGE(PG8_SB(0, 0), cB, voffB); PG8_STAGE(PG8_SB(0, 1), cB + hstep, voffB); PG8_STAGE(PG8_SA(0, 0), cA, voffA); PG8_STAGE(PG8_SA(0, 1), cA + hstep, voffA);
        if (wr == 1) PG8_BAR;
        PG8_WAIT_V(2); PG8_BAR;
        PG8_STAGE(PG8_SB(1, 0), cB + kstep, voffB); PG8_STAGE(PG8_SA(1, 0), cA + kstep, voffA); PG8_STAGE(PG8_SB(1, 1), cB + hstep + kstep, voffB);
        PG8_WAIT_V(6); PG8_BAR;
    } else {
        PG8_STAGE(PG8_SB(0, 0), cB, voffB); PG8_STAGE(PG8_SA(0, 0), cA, voffA); PG8_STAGE(PG8_SB(0, 1), cB + hstep, voffB); PG8_STAGE(PG8_SA(0, 1), cA + hstep, voffA);
        if (wr == 1) PG8_BAR;
        PG8_WAIT_V(4); PG8_BAR;
        PG8_STAGE(PG8_SB(1, 0), cB + kstep, voffB); PG8_STAGE(PG8_SA(1, 0), cA + kstep, voffA); PG8_STAGE(PG8_SB(1, 1), cB + hstep + kstep, voffB);
        PG8_WAIT_V(6); PG8_BAR;
    }
    for (;;) {
        const bool has_next = S.next(ui + 1, nxt);
        const char* nA = has_next ? (const char*)g.A + (size_t)nxt.pm * tstep : cA; const char* nB = has_next ? (const char*)g.Bt + (size_t)nxt.pn * tstep : cB;
        for (int t = 0; t < nt; t += 2) {
            const bool last = (t == nt - 2);
            const char* a1 = cA + (size_t)(t + 1) * kstep;
            const char* a2 = last ? nA : cA + (size_t)(t + 2) * kstep; const char* b2 = last ? nB : cB + (size_t)(t + 2) * kstep;
            const char* a3 = a2 + kstep; const char* b3 = b2 + kstep;
            if (last && has_next) S.a_ready(nxt);
            if constexpr (SP2) {
            PG8_LDB(B0, 0, 0); PG8_LDB(B1, 0, 1); PG8_SCHED; PG8_LDA(At, 0, 0); PG8_STAGE(PG8_SA(1, 1), a1 + hstep, voffA);
            PG8_WAIT_V(8); PG8_WAIT_L(0); PG8_BAR; PG8_MMA(0, 0, At, B0); PG8_MMA(0, 1, At, B1); PG8_BAR; PG8_SCHED;
            PG8_LDA(At, 0, 1); PG8_STAGE(PG8_SB(0, 0), b2, voffB); PG8_STAGE(PG8_SB(0, 1), b2 + hstep, voffB); PG8_STAGE(PG8_SA(0, 0), a2, voffA);
            PG8_WAIT_V(8); PG8_WAIT_L(0); PG8_BAR; PG8_MMA(1, 0, At, B0); PG8_MMA(1, 1, At, B1); PG8_BAR; PG8_SCHED;
            PG8_LDB(B0, 1, 0); PG8_LDB(B1, 1, 1); PG8_SCHED; PG8_LDA(At, 1, 0); PG8_STAGE(PG8_SA(0, 1), a2 + hstep, voffA);
            PG8_WAIT_V(8); PG8_WAIT_L(0); PG8_BAR; PG8_MMA(0, 0, At, B0); PG8_MMA(0, 1, At, B1); PG8_BAR; PG8_SCHED;
            PG8_LDA(At, 1, 1); PG8_STAGE(PG8_SB(1, 0), b3, voffB); PG8_STAGE(PG8_SB(1, 1), b3 + hstep, voffB); PG8_STAGE(PG8_SA(1, 0), a3, voffA);
            PG8_WAIT_V(8); PG8_WAIT_L(0); PG8_BAR; PG8_MMA(1, 0, At, B0); PG8_MMA(1, 1, At, B1); PG8_BAR; PG8_SCHED;
            } else {
            PG8_LDB(B0, 0, 0); PG8_SCHED; PG8_LDA(At, 0, 0); PG8_STAGE(PG8_SA(1, 1), a1 + hstep, voffA);
            PG8_WAIT_L(8); PG8_BAR; PG8_WAIT_L(0); PG8_MMA(0, 0, At, B0); PG8_BAR; PG8_SCHED;
            PG8_LDB(B1, 0, 1); PG8_STAGE(PG8_SB(0, 0), b2, voffB);
            PG8_BAR; PG8_WAIT_L(0); PG8_MMA(0, 1, At, B1); PG8_BAR;
            PG8_LDA(At, 0, 1); PG8_STAGE(PG8_SA(0, 0), a2, voffA);
            PG8_BAR; PG8_WAIT_L(0); PG8_MMA(1, 0, At, B0); PG8_BAR; PG8_SCHED;
            PG8_STAGE(PG8_SB(0, 1), b2 + hstep, voffB);
            PG8_WAIT_V(6); PG8_BAR; PG8_MMA(1, 1, At, B1); PG8_BAR;
            PG8_LDB(B0, 1, 0); PG8_SCHED; PG8_LDA(At, 1, 0); PG8_STAGE(PG8_SA(0, 1), a2 + hstep, voffA);
            PG8_WAIT_L(8); PG8_BAR; PG8_WAIT_L(0); PG8_MMA(0, 0, At, B0); PG8_BAR; PG8_SCHED;
            PG8_LDB(B1, 1, 1); PG8_STAGE(PG8_SB(1, 0), b3, voffB);
            PG8_BAR; PG8_WAIT_L(0); PG8_MMA(0, 1, At, B1); PG8_BAR;
            PG8_LDA(At, 1, 1); PG8_STAGE(PG8_SA(1, 0), a3, voffA);
            PG8_BAR; PG8_WAIT_L(0); PG8_MMA(1, 0, At, B0); PG8_BAR; PG8_SCHED;
            PG8_STAGE(PG8_SB(1, 1), b3 + hstep, voffB);
            PG8_WAIT_V(6); PG8_BAR; PG8_MMA(1, 1, At, B1); PG8_BAR;
            }
        }
        if constexpr (ALIGN_EPI) { if (wr == 0) PG8_BAR; }
        if constexpr (!Epi::AFTER_DRAIN) { E(acc, cur, wr, wc, fr, fq); S.done(cur); }
        if (!has_next) break;
#pragma unroll
        for (int a = 0; a < 2; ++a)
#pragma unroll
            for (int b = 0; b < 2; ++b)
#pragma unroll
                for (int m = 0; m < 4; ++m)
#pragma unroll
                    for (int n = 0; n < 2; ++n) acc[a][b][m][n] = (f32x4){0.f, 0.f, 0.f, 0.f};
        cur = nxt; cA = nA; cB = nB; ++ui;
        if constexpr (ALIGN_EPI) { if (wr == 1) PG8_BAR; }
    }
    PG8_WAIT_V(0);
    if constexpr (!ALIGN_EPI) { if (wr == 0) PG8_BAR; }
    PG8_BAR;
    if constexpr (Epi::AFTER_DRAIN) { E.fused(acc, cur, wr, wc, fr, fq, lds, wid, lane); S.done(cur); }
#undef PG8_SA
#undef PG8_SB
#undef PG8_STAGE
#undef PG8_LDA
#undef PG8_LDB
#undef PG8_MMA
#undef PG8_WAIT_V
#undef PG8_WAIT_L
#undef PG8_BAR
#undef PG8_SCHED
}
}
constexpr int NTHR = 512;
constexpr int SEQ = 8192, NTOK = 16384, DM = 1024, INC = 4104, PJ = 4096, DMIX = 1536, DFF = 2816, DEPTH = 2;
constexpr int C_Q = 0, C_K = 512, C_V = 1024, C_Z = 1536, C_XBC = 2048, C_GL = 3072, C_XL = 3584;
constexpr float LOG2E = 1.4426950408889634f;
constexpr size_t MiB = 1u << 20;
constexpr size_t WS_DT = 1 * MiB, WS_LSE = WS_DT + 512 * 1024, WS_AGA = 2 * MiB, WS_AGH = WS_AGA + 512 * 1024, WS_CD = 64 * 1024, WS_RSP = 3 * MiB;
constexpr size_t WS_WIN = 4 * MiB, WS_WOUT = 12 * MiB, WS_WGU = 15 * MiB, WS_WD = 26 * MiB;
constexpr size_t WS_XN = 32 * MiB;
constexpr size_t WS_ST = WS_XN, WS_PL = WS_XN + 16 * MiB;
constexpr size_t WS_PROJ = 64 * MiB;
constexpr size_t WS_MIX = 192 * MiB;
constexpr size_t WS_WOUT1 = 240 * MiB, WS_WGU1 = 243 * MiB;
constexpr size_t WS_END = 254 * MiB;
constexpr int LDS_BYTES = 153600;

#define LAS __attribute__((address_space(3)))
typedef unsigned short bf16;
typedef float f32x4 __attribute__((ext_vector_type(4)));
typedef float f32x2 __attribute__((ext_vector_type(2)));
typedef short bf16x8 __attribute__((ext_vector_type(8)));
typedef short bf16x4 __attribute__((ext_vector_type(4)));
typedef unsigned u32x4 __attribute__((ext_vector_type(4)));
typedef unsigned u32x2 __attribute__((ext_vector_type(2)));
#define LDS_WAIT() asm volatile("s_waitcnt lgkmcnt(0)" ::: "memory")

typedef __bf16 hbf16x2 __attribute__((ext_vector_type(2)));
__device__ __forceinline__ unsigned pk2(float lo, float hi) { const f32x2 v = {lo, hi}; const hbf16x2 b = __builtin_convertvector(v, hbf16x2); return __builtin_bit_cast(unsigned, b); }
__device__ __forceinline__ unsigned f2bf(float f) { return pk2(f, 0.f) & 0xffffu; }
__device__ __forceinline__ float bf2f(unsigned short b) { return __builtin_bit_cast(float, (unsigned)b << 16); }
__device__ __forceinline__ float bflo(unsigned w) { return __builtin_bit_cast(float, w << 16); }
__device__ __forceinline__ float bfhi(unsigned w) { return __builtin_bit_cast(float, w & 0xffff0000u); }
__device__ __forceinline__ float wave_sum(float v) {
#pragma unroll
    for (int o = 1; o < 64; o <<= 1) v += __shfl_xor(v, o);
    return v;
}
__device__ __forceinline__ float softplusf(float x) { return fmaxf(x, 0.f) + log1pf(__expf(-fabsf(x))); }
__device__ __forceinline__ float fexp(float x) { return __builtin_amdgcn_exp2f(x * LOG2E); }
__device__ __forceinline__ float sigmoidf_(float x) { return __builtin_amdgcn_rcpf(1.0f + fexp(-x)); }
__device__ __forceinline__ float siluf_(float x) { return x * __builtin_amdgcn_rcpf(1.0f + fexp(-x)); }
__device__ __forceinline__ float gelu_tanh(float x) { const float u = 0.7978845608028654f * (x + 0.044715f * x * x * x); return x * __builtin_amdgcn_rcpf(1.0f + fexp(-2.0f * u)); }
__device__ __forceinline__ f32x4 mfma16(bf16x8 a, bf16x8 b, f32x4 c) { return __builtin_amdgcn_mfma_f32_16x16x32_bf16(a, b, c, 0, 0, 0); }
__device__ __forceinline__ bf16x8 cat8(u32x2 lo, u32x2 hi) { u32x4 w; w.x = lo.x; w.y = lo.y; w.z = hi.x; w.w = hi.y; return __builtin_bit_cast(bf16x8, w); }

struct Params {
    const float* in[22];
    float* out; unsigned char* ws;
};

struct WtItem { const float* src; const float* gain; bf16* dst; int ldw, K; };
struct WtDst { bf16 *in, *out, *gu, *d; };
__device__ __forceinline__ WtItem wt_decode(const Params& p, int l, const WtDst& D, int it) {
    const float* w_in = p.in[2] + (size_t)l * DM * INC; const float* g1 = p.in[1] + l * DM;
    const float* w_out = p.in[16] + (size_t)l * DMIX * DM;
    const float* g2 = p.in[17] + l * DM; const float* w_gate = p.in[18] + (size_t)l * DM * DFF; const float* w_up = p.in[19] + (size_t)l * DM * DFF;
    const float* w_down = p.in[20] + (size_t)l * DFF * DM;
    bf16* WinT = D.in; bf16* WoutT = D.out; bf16* WguT = D.gu; bf16* WdT = D.d;
    constexpr int I_IN = (DM / 64) * (PJ / 32), I_OUT = (DMIX / 64) * (DM / 32), I_GU = (DM / 64) * (2 * DFF / 32);
    WtItem w; int r = it;
    if (r < I_IN) { const int nb = r % (PJ / 32), kb = r / (PJ / 32), n0 = 32 * nb, k0 = 64 * kb; w.src = w_in + (size_t)k0 * INC + (n0 < 3072 ? n0 : n0 + 8); w.gain = g1 + k0; w.dst = WinT + (size_t)n0 * DM + k0; w.ldw = INC; w.K = DM; return w; } r -= I_IN;
    if (r < I_OUT) { const int nb = r % (DM / 32), kb = r / (DM / 32), k0 = 64 * kb; w.src = w_out + (size_t)k0 * DM + 32 * nb; w.gain = nullptr; w.dst = WoutT + (size_t)(32 * nb) * DMIX + k0; w.ldw = DM; w.K = DMIX; return w; } r -= I_OUT;
    if (r < I_GU) { const int nb = r % (2 * DFF / 32), kb = r / (2 * DFF / 32), n0 = 32 * nb, pn = n0 >> 8, wi = n0 & 255, k0 = 64 * kb;
        w.src = (wi < 128 ? w_gate : w_up) + (size_t)k0 * DFF + 128 * pn + (wi & 127); w.gain = g2 + k0; w.dst = WguT + (size_t)n0 * DM + k0; w.ldw = DFF; w.K = DM; return w; } r -= I_GU;
    { const int nb = r % (DM / 32), kb = r / (DM / 32), k0 = 64 * kb; w.src = w_down + (size_t)k0 * DM + 32 * nb; w.gain = nullptr; w.dst = WdT + (size_t)(32 * nb) * DFF + k0; w.ldw = DM; w.K = DFF; return w; }
}
constexpr int WT_IO = (DM / 64) * (PJ / 32) + (DMIX / 64) * (DM / 32);
constexpr int WT_EARLY = (DM / 64) * (PJ / 32) + (DMIX / 64) * (DM / 32) + (DM / 64) * (2 * DFF / 32), WT_ALL = WT_EARLY + (DFF / 64) * (DM / 32);
__device__ __forceinline__ void weights_phase(const Params& p, int l, const WtDst& D, int lo, int NITEMS, LAS unsigned char* lds, int gw, int NGW, int wave, int lane) {
    LAS float* scr = (LAS float*)(lds + wave * 16384);
    if (lo + gw >= NITEMS) return;
    WtItem nx = wt_decode(p, l, D, lo + gw);
    float wn[32];
#pragma unroll
    for (int i = 0; i < 32; ++i) wn[i] = nx.src[(size_t)(2 * i + (lane >> 5)) * nx.ldw + (lane & 31)];
#pragma unroll 1
    for (int it = lo + gw; it < NITEMS; it += NGW) {
        const WtItem cu = nx; float wv[32];
#pragma unroll
        for (int i = 0; i < 32; ++i) wv[i] = wn[i];
        if (it + NGW < NITEMS) { nx = wt_decode(p, l, D, it + NGW);
#pragma unroll
            for (int i = 0; i < 32; ++i) wn[i] = nx.src[(size_t)(2 * i + (lane >> 5)) * nx.ldw + (lane & 31)]; }
        if (cu.gain) {
#pragma unroll
            for (int i = 0; i < 32; ++i) wv[i] *= cu.gain[2 * i + (lane >> 5)]; }
#pragma unroll
        for (int i = 0; i < 32; ++i) scr[(2 * i + (lane >> 5)) * 33 + (lane & 31)] = wv[i];
        LDS_WAIT(); asm volatile("" ::: "memory");
        const int c = lane & 7;
#pragma unroll
        for (int j = 0; j < 4; ++j) { const int n = (lane >> 3) + 8 * j; const LAS float* s = scr + (8 * c) * 33 + n;
            u32x4 o; o.x = pk2(s[0 * 33], s[1 * 33]); o.y = pk2(s[2 * 33], s[3 * 33]); o.z = pk2(s[4 * 33], s[5 * 33]); o.w = pk2(s[6 * 33], s[7 * 33]);
            *(u32x4*)(cu.dst + (size_t)n * cu.K + 8 * c) = o; }
        LDS_WAIT(); asm volatile("" ::: "memory");
    }
}
template <bool IN_BF16> __device__ __forceinline__ void load_row(const void* x, size_t m, int lane, f32x4 (&v)[4]) {
    if (IN_BF16) { const u32x2* xr = (const u32x2*)((const bf16*)x + m * DM) + lane;
#pragma unroll
        for (int j = 0; j < 4; ++j) { const u32x2 w = xr[64 * j]; v[j] = (f32x4){bflo(w.x), bfhi(w.x), bflo(w.y), bfhi(w.y)}; } }
    else { const f32x4* xr = (const f32x4*)((const float*)x + m * DM) + lane;
#pragma unroll
        for (int j = 0; j < 4; ++j) v[j] = xr[64 * j]; }
}
template <bool IN_BF16> __device__ __forceinline__ void norm_dt_phase(const void* xin, bf16* XN, const float* g, const float* w_in, const float* dt_bias, float* DT, int gw, int NGW, int lane, LAS unsigned char* lds, int tid) {
    LAS float* wtab = (LAS float*)lds;
    __syncthreads();
    for (int k = tid; k < DM; k += NTHR) { const float gk = g[k]; const f32x4* wp = (const f32x4*)(w_in + (size_t)k * INC + 3072); *(LAS f32x4*)(wtab + 8 * k) = wp[0] * gk; *(LAS f32x4*)(wtab + 8 * k + 4) = wp[1] * gk; }
    __syncthreads();
    float wd[4][4][8];
#pragma unroll
    for (int j = 0; j < 4; ++j)
#pragma unroll
        for (int e = 0; e < 4; ++e) { const int k = 256 * j + 4 * lane + e; const f32x4 a = *(const LAS f32x4*)(wtab + 8 * k), b = *(const LAS f32x4*)(wtab + 8 * k + 4);
#pragma unroll
            for (int q = 0; q < 4; ++q) { wd[j][e][q] = a[q]; wd[j][e][4 + q] = b[q]; } }
    const float bias = dt_bias[lane & 7];
    f32x4 vn[4];
    if (gw < NTOK) load_row<IN_BF16>(xin, (size_t)gw, lane, vn);
#pragma unroll 1
    for (int m = gw; m < NTOK; m += NGW) {
        f32x4 v[4]; float ss = 0.f; float d[8];
#pragma unroll
        for (int j = 0; j < 4; ++j) v[j] = vn[j];
        if (m + NGW < NTOK) load_row<IN_BF16>(xin, (size_t)(m + NGW), lane, vn);
#pragma unroll
        for (int q = 0; q < 8; ++q) d[q] = 0.f;
#pragma unroll
        for (int j = 0; j < 4; ++j) {
#pragma unroll
            for (int e = 0; e < 4; ++e) { ss += v[j][e] * v[j][e];
#pragma unroll
                for (int q = 0; q < 8; ++q) d[q] += v[j][e] * wd[j][e][q]; } }
        ss = wave_sum(ss); const float rs = 1.0f / sqrtf(ss * (1.0f / DM) + 1e-6f);
#pragma unroll
        for (int q = 0; q < 8; ++q) d[q] = wave_sum(d[q]);
        unsigned long long* o8 = (unsigned long long*)(XN + (size_t)m * DM) + lane;
#pragma unroll
        for (int j = 0; j < 4; ++j) o8[64 * j] = (unsigned long long)pk2(v[j][0] * rs, v[j][1] * rs) | ((unsigned long long)pk2(v[j][2] * rs, v[j][3] * rs) << 32);
        float dv = d[0];
#pragma unroll
        for (int q = 1; q < 8; ++q) dv = (lane == q) ? d[q] : dv;
        if (lane < 8) DT[(size_t)m * 8 + lane] = softplusf(dv * rs + bias);
    }
}
__device__ __forceinline__ void norm_phase(const bf16* xin, bf16* XN, int gw, int NGW, int lane) {
    f32x4 vn[4];
    if (gw < NTOK) load_row<true>(xin, (size_t)gw, lane, vn);
#pragma unroll 1
    for (int m = gw; m < NTOK; m += NGW) {
        f32x4 v[4]; float ss = 0.f;
#pragma unroll
        for (int j = 0; j < 4; ++j) v[j] = vn[j];
        if (m + NGW < NTOK) load_row<true>(xin, (size_t)(m + NGW), lane, vn);
#pragma unroll
        for (int j = 0; j < 4; ++j) ss += (v[j][0] * v[j][0] + v[j][1] * v[j][1]) + (v[j][2] * v[j][2] + v[j][3] * v[j][3]);
        ss = wave_sum(ss); const float rs = 1.0f / sqrtf(ss * (1.0f / DM) + 1e-6f);
        unsigned long long* o8 = (unsigned long long*)(XN + (size_t)m * DM) + lane;
#pragma unroll
        for (int j = 0; j < 4; ++j) o8[64 * j] = (unsigned long long)pk2(v[j][0] * rs, v[j][1] * rs) | ((unsigned long long)pk2(v[j][2] * rs, v[j][3] * rs) << 32);
    }
}
__device__ __forceinline__ void final_norm_phase(const bf16* xin, float* out, const float* g, int gw, int NGW, int lane) {
    f32x4 gv[4];
#pragma unroll
    for (int j = 0; j < 4; ++j) gv[j] = ((const f32x4*)g)[64 * j + lane];
    f32x4 vn[4];
    if (gw < NTOK) load_row<true>(xin, (size_t)gw, lane, vn);
#pragma unroll 1
    for (int m = gw; m < NTOK; m += NGW) {
        f32x4 v[4]; float ss = 0.f;
#pragma unroll
        for (int j = 0; j < 4; ++j) v[j] = vn[j];
        if (m + NGW < NTOK) load_row<true>(xin, (size_t)(m + NGW), lane, vn);
#pragma unroll
        for (int j = 0; j < 4; ++j) ss += (v[j][0] * v[j][0] + v[j][1] * v[j][1]) + (v[j][2] * v[j][2] + v[j][3] * v[j][3]);
        ss = wave_sum(ss); const float rs = 1.0f / sqrtf(ss * (1.0f / DM) + 1e-6f);
        f32x4* xr = (f32x4*)(out + (size_t)m * DM) + lane;
#pragma unroll
        for (int j = 0; j < 4; ++j) xr[64 * j] = v[j] * rs * gv[j];
    }
}
constexpr int KP = 72, ATT_KB = 256 * KP * 2, ATT_VB = ATT_KB, ATT_K0 = 0, ATT_V0 = 2 * ATT_KB;
typedef short v4i16_t __attribute__((ext_vector_type(4)));
__device__ __forceinline__ u32x2 lds_tr16(const LAS bf16* p) { return __builtin_bit_cast(u32x2, __builtin_amdgcn_ds_read_tr16_b64_v4i16((LAS v4i16_t*)p)); }
static_assert(ATT_V0 + 2 * ATT_VB <= LDS_BYTES - 1024, "attention LDS map");
#define ATT_DECODE(it_, b_, h_, r_, nb_) const int nb_ = (it_) % nblk, t2_##b_ = (it_) / nblk, r_ = t2_##b_ % dil, t3_##b_ = t2_##b_ / dil, h_ = t3_##b_ & 7, b_ = t3_##b_ >> 3
#define ATT_ISSUE(it_) do { ATT_DECODE(it_, bI, hI, rI, nbI); const int j0I = 128 * (nbI - 1); \
    _Pragma("unroll") for (int u = 0; u < 4; ++u) { const int id = tid + NTHR * u, key = id >> 3, dp = id & 7; int jj = j0I + key; jj = jj < 0 ? 0 : jj; \
        const bf16* rp = PROJ + ((size_t)bI * SEQ + rI + (size_t)dil * jj) * PJ + hI * 64 + 8 * dp; kreg[u] = *(const bf16x8*)(rp + C_K); vreg[u] = *(const bf16x8*)(rp + C_V); } \
    { const size_t qrowI = (size_t)bI * SEQ + rI + (size_t)dil * (128 * nbI + 16 * wid + fr); \
      _Pragma("unroll") for (int ks = 0; ks < 2; ++ks) qn[ks] = *(const bf16x8*)(PROJ + qrowI * PJ + C_Q + hI * 64 + 32 * ks + 8 * fq); } } while (0)
#define ATT_WRITE(buf_) do { LAS bf16* KBw = (LAS bf16*)(lds + ATT_K0 + (buf_) * ATT_KB); LAS bf16* VTw = (LAS bf16*)(lds + ATT_V0 + (buf_) * ATT_VB); \
    _Pragma("unroll") for (int u = 0; u < 4; ++u) { const int id = tid + NTHR * u, key = id >> 3, dp = id & 7; *(LAS bf16x8*)(KBw + key * KP + 8 * dp) = kreg[u]; *(LAS bf16x8*)(VTw + key * KP + 8 * dp) = vreg[u]; } } while (0)
__device__ __forceinline__ void attn_phase(LAS unsigned char* lds, const bf16* PROJ, bf16* MIX, float* LSE, int pat, int first  , int G, int tid) {
    asm volatile("" : "+v"(tid)); const int lane = tid & 63, wid = __builtin_amdgcn_readfirstlane(tid >> 6);
    const int fr = lane & 15, fq = lane >> 4;
    const int dil = pat == 0 ? 1 : (pat == 1 ? 4 : 16), nblk = SEQ / dil / 128;
    int it = (int)(((long)first * 1024) / G); const int it_end = (int)(((long)(first + 1) * 1024) / G); if (it >= it_end) return;
    bf16x8 kreg[4], vreg[4], qn[2], qf[2];
    ATT_ISSUE(it); ATT_WRITE(0); qf[0] = qn[0]; qf[1] = qn[1];
    __syncthreads();
#pragma unroll 1
    for (int n = 0;; ++n) {
        const int itn = it + 1; const bool has_next = itn < it_end;
        if (has_next) ATT_ISSUE(itn);
        ATT_DECODE(it, b, h, r, nb);
        const LAS bf16* KB = (const LAS bf16*)(lds + ATT_K0 + (n & 1) * ATT_KB); const LAS bf16* Vt = (const LAS bf16*)(lds + ATT_V0 + (n & 1) * ATT_VB);
        const int qi = 16 * wid + fr; const size_t qrow = (size_t)b * SEQ + r + (size_t)dil * (128 * nb + qi);
        bf16* op = MIX + qrow * DMIX + h * 64 + 4 * fq; float* lp = LSE + qrow * 8 + h;
        u32x2 pr[4]; float lpv = 0.f;
        if (pat > 0) { lpv = *lp;
#pragma unroll
            for (int dt = 0; dt < 4; ++dt) pr[dt] = *(const u32x2*)(op + 16 * dt); }
        const float sc = 0.125f * LOG2E, sl = exp2f(-(float)(h + 1)) * LOG2E * (float)dil, cl = -sl * (float)(128 + fr - 4 * fq);
        f32x4 s[10]; float mx = -1e30f; unsigned tvm = 0u;
#pragma unroll
        for (int jt = 0; jt < 9; ++jt) {
            const bool tv = (wid + jt <= 15) && (nb > 0 || wid + jt >= 8);
            if (tv) { tvm |= 1u << jt; const LAS bf16* kp = KB + (16 * (wid + jt) + fr) * KP + 8 * fq;
                f32x4 a = {0.f, 0.f, 0.f, 0.f}; a = mfma16(*(const LAS bf16x8*)kp, qf[0], a); a = mfma16(*(const LAS bf16x8*)(kp + 32), qf[1], a);
#pragma unroll
                for (int v = 0; v < 4; ++v) { float x = a[v] * sc + (cl + sl * (float)(16 * jt + v));
                    if (jt == 0) x = (4 * fq + v >= fr) ? x : -1e30f;
                    if (jt == 8) x = (4 * fq + v <= fr) ? x : -1e30f;
                    a[v] = x; mx = fmaxf(mx, x); }
                s[jt] = a; }
            else s[jt] = (f32x4){-1e30f, -1e30f, -1e30f, -1e30f};
        }
        mx = fmaxf(mx, __shfl_xor(mx, 16)); mx = fmaxf(mx, __shfl_xor(mx, 32));
        float lsum = 0.f;
#pragma unroll
        for (int jt = 0; jt < 9; ++jt) {
            if ((tvm >> jt) & 1u) {
#pragma unroll
                for (int v = 0; v < 4; ++v) { const float pv = __builtin_amdgcn_exp2f(s[jt][v] - mx); s[jt][v] = pv; lsum += pv; } }
            else s[jt] = (f32x4){0.f, 0.f, 0.f, 0.f};
        }
        s[9] = (f32x4){0.f, 0.f, 0.f, 0.f};
        lsum += __shfl_xor(lsum, 16); lsum += __shfl_xor(lsum, 32);
        f32x4 o[4];
#pragma unroll
        for (int dt = 0; dt < 4; ++dt) o[dt] = (f32x4){0.f, 0.f, 0.f, 0.f};
#pragma unroll
        for (int u = 0; u < 5; ++u) {
            u32x4 pw; pw.x = pk2(s[2 * u][0], s[2 * u][1]); pw.y = pk2(s[2 * u][2], s[2 * u][3]); pw.z = pk2(s[2 * u + 1][0], s[2 * u + 1][1]); pw.w = pk2(s[2 * u + 1][2], s[2 * u + 1][3]);
            const bf16x8 pb = __builtin_bit_cast(bf16x8, pw);
            int kt0 = wid + 2 * u, kt1 = kt0 + 1; kt0 = kt0 > 15 ? 15 : kt0; kt1 = kt1 > 15 ? 15 : kt1;
#pragma unroll
            for (int dt = 0; dt < 4; ++dt) { const LAS bf16* vr = Vt + (4 * fq + (fr >> 2)) * KP + 16 * dt + 4 * (fr & 3);
                const u32x2 lo = lds_tr16(vr + 16 * kt0 * KP), hi = lds_tr16(vr + 16 * kt1 * KP);
                o[dt] = mfma16(cat8(lo, hi), pb, o[dt]); }
        }
        const float inv = __builtin_amdgcn_rcpf(lsum); float lse = mx + __builtin_amdgcn_logf(lsum);
        float c1 = 0.f, c2 = inv;
        if (pat > 0) { const float M = fmaxf(lpv, lse); const float w1 = __builtin_amdgcn_exp2f(lpv - M), w2 = __builtin_amdgcn_exp2f(lse - M), iw = __builtin_amdgcn_rcpf(w1 + w2); c1 = w1 * iw; c2 = w2 * iw * inv; lse = M + __builtin_amdgcn_logf(w1 + w2); }
#pragma unroll
        for (int dt = 0; dt < 4; ++dt) { f32x4 ov = o[dt] * c2;
            if (pat > 0) { ov[0] += c1 * bflo(pr[dt].x); ov[1] += c1 * bfhi(pr[dt].x); ov[2] += c1 * bflo(pr[dt].y); ov[3] += c1 * bfhi(pr[dt].y); }
            u32x2 w; w.x = pk2(ov[0], ov[1]); w.y = pk2(ov[2], ov[3]); *(u32x2*)(op + 16 * dt) = w; }
        if (fq == 0) *lp = lse;
        if (has_next) { ATT_WRITE((n + 1) & 1); qf[0] = qn[0]; qf[1] = qn[1]; }
        __syncthreads();
        if (!has_next) break;
        it = itn;
    }
}

constexpr int XP = 136, XR = 272;
constexpr int SSD_XT = 0, SSD_B = 256 * XP * 2, SSD_C = SSD_B + 128 * XP * 2, SSD_TAB = SSD_C + 128 * XP * 2, SSD_END = SSD_TAB + 4096 + 64 + 512;
template <int PITCH> __device__ __forceinline__ void ssd_conv_pair(const bf16* PROJ, int b, int c, int th, int xcol, const float* cw, const float* cb, LAS bf16* dst, int dcol) {
    const f32x2 w0 = *(const f32x2*)(cw + xcol), w1 = *(const f32x2*)(cw + 1024 + xcol), w2 = *(const f32x2*)(cw + 2048 + xcol), w3 = *(const f32x2*)(cw + 3072 + xcol), bb = *(const f32x2*)(cb + xcol);
    const bf16* src = PROJ + ((size_t)b * SEQ + (size_t)c * 128 + 64 * th) * PJ + C_XBC + xcol;
    unsigned h3 = 0u, h2 = 0u, h1 = 0u;
    if (c > 0 || th > 0) { h3 = *(const unsigned*)(src - 3 * (ptrdiff_t)PJ); h2 = *(const unsigned*)(src - 2 * (ptrdiff_t)PJ); h1 = *(const unsigned*)(src - (ptrdiff_t)PJ); }
    f32x2 xm3 = {bflo(h3), bfhi(h3)}, xm2 = {bflo(h2), bfhi(h2)}, xm1 = {bflo(h1), bfhi(h1)};
#pragma unroll 1
    for (int tb = 0; tb < 2; ++tb) {
        unsigned xv[32];
#pragma unroll
        for (int e = 0; e < 32; ++e) xv[e] = *(const unsigned*)(src + (size_t)(32 * tb + e) * PJ);
#pragma unroll
        for (int e = 0; e < 32; ++e) { const f32x2 x = {bflo(xv[e]), bfhi(xv[e])}; const f32x2 y = bb + w0 * xm3 + w1 * xm2 + w2 * xm1 + w3 * x; xm3 = xm2; xm2 = xm1; xm1 = x;
            const int tok = 64 * th + 32 * tb + e; *(LAS unsigned*)(dst + tok * PITCH + dcol) = pk2(siluf_(y.x), siluf_(y.y)); }
    }
}
__device__ __forceinline__ float ssd_cumsum(const float* DT, const float* a_log, int b, int c, int g, int tid, int wid, int lane, LAS float* tot, float& dtv) {
    const int hh = tid >> 7, i = tid & 127;
    dtv = DT[((size_t)b * SEQ + c * 128 + i) * 8 + 4 * g + hh];
    float v = dtv * (-fexp(a_log[4 * g + hh]));
#pragma unroll
    for (int d = 1; d < 64; d <<= 1) { const float t = __shfl_up(v, d); if (lane >= d) v += t; }
    if (lane == 63) tot[wid] = v;
    __syncthreads();
    if (wid & 1) v += tot[wid - 1];
    return v;
}
__device__ __forceinline__ void ssd_states_item(LAS unsigned char* lds, const Params& p, int l, const bf16* PROJ, const float* DT, bf16* ST, float* CD, int it, int tid) {
    asm volatile("" : "+v"(tid)); const int lane = tid & 63, wid = __builtin_amdgcn_readfirstlane(tid >> 6);
    const int fr = lane & 15, fq = lane >> 4;
    const int g = it & 1, c = (it >> 1) & 63, b = it >> 7;
    LAS bf16* Xt = (LAS bf16*)(lds + SSD_XT); LAS bf16* Bt = (LAS bf16*)(lds + SSD_B);
    LAS float* wts = (LAS float*)(lds + SSD_TAB); LAS float* tot = wts + 1024;
    const float* cw = p.in[3] + (size_t)l * 4 * 1024; const float* cb = p.in[4] + l * 1024;
    { const int cp = tid & 255, th = tid >> 8;
      if (cp < 128) ssd_conv_pair<XR>(PROJ, b, c, th, 256 * g + 2 * cp, cw, cb, Xt, 2 * cp);
      else if (cp < 192) ssd_conv_pair<XP>(PROJ, b, c, th, 512 + 128 * g + 2 * (cp - 128), cw, cb, Bt, 2 * (cp - 128)); }
    float dtv; const float acs = ssd_cumsum(DT, p.in[6] + l * 8, b, c, g, tid, wid, lane, tot, dtv);
    { const int hh = tid >> 7, i = tid & 127; if (i == 127) { tot[8 + hh] = acs; CD[((size_t)b * 64 + c) * 8 + 4 * g + hh] = fexp(acs); } }
    __syncthreads();
    { const int hh = tid >> 7, i = tid & 127; wts[hh * 128 + i] = fexp(tot[8 + hh] - acs) * dtv; }
    __syncthreads();
    const int hh = wid >> 1, nh = wid & 1;
    f32x4 acc[4][4];
#pragma unroll
    for (int pt = 0; pt < 4; ++pt)
#pragma unroll
        for (int nt = 0; nt < 4; ++nt) acc[pt][nt] = (f32x4){0.f, 0.f, 0.f, 0.f};
#pragma unroll
    for (int ks = 0; ks < 4; ++ks) {
        const f32x4 wa = *(const LAS f32x4*)(wts + hh * 128 + 32 * ks + 8 * fq), wb = *(const LAS f32x4*)(wts + hh * 128 + 32 * ks + 8 * fq + 4);
        bf16x8 bfr[4];
#pragma unroll
        for (int nt = 0; nt < 4; ++nt) { const LAS bf16* bp = Bt + (32 * ks + 8 * fq + (fr >> 2)) * XP + 16 * (4 * nh + nt) + 4 * (fr & 3);
            bfr[nt] = cat8(lds_tr16(bp), lds_tr16(bp + 4 * XP)); }
#pragma unroll
        for (int pt = 0; pt < 4; ++pt) {
            const LAS bf16* xp_ = Xt + (32 * ks + 8 * fq + (fr >> 2)) * XR + 64 * hh + 16 * pt + 4 * (fr & 3); const u32x2 xlo = lds_tr16(xp_), xhi = lds_tr16(xp_ + 4 * XR);
            u32x4 xr; xr.x = xlo.x; xr.y = xlo.y; xr.z = xhi.x; xr.w = xhi.y;
            u32x4 xs; xs.x = pk2(bflo(xr.x) * wa[0], bfhi(xr.x) * wa[1]); xs.y = pk2(bflo(xr.y) * wa[2], bfhi(xr.y) * wa[3]);
            xs.z = pk2(bflo(xr.z) * wb[0], bfhi(xr.z) * wb[1]); xs.w = pk2(bflo(xr.w) * wb[2], bfhi(xr.w) * wb[3]);
            const bf16x8 xf = __builtin_bit_cast(bf16x8, xs);
#pragma unroll
            for (int nt = 0; nt < 4; ++nt) acc[pt][nt] = mfma16(bfr[nt], xf, acc[pt][nt]);
        }
    }
    bf16* sp = ST + ((((size_t)b * 64 + c) * 8 + 4 * g + hh) * 64) * 128;
#pragma unroll
    for (int pt = 0; pt < 4; ++pt)
#pragma unroll
        for (int nt = 0; nt < 4; ++nt) { u32x2 w; w.x = pk2(acc[pt][nt][0], acc[pt][nt][1]); w.y = pk2(acc[pt][nt][2], acc[pt][nt][3]);
            *(u32x2*)(sp + (size_t)(16 * pt + fr) * 128 + 16 * (4 * nh + nt) + 4 * fq) = w; }
    __syncthreads();
}
constexpr int YP = 264, SSD_YS_WAVE = 16 * YP * 2;
static_assert(8 * SSD_YS_WAVE <= SSD_TAB - SSD_B, "y staging fits the B|C images");
__device__ __forceinline__ void ssd_out_item(LAS unsigned char* lds, const Params& p, int l, const bf16* PROJ, const float* DT, const bf16* ST, bf16* MIX, int it, int tid) {
    asm volatile("" : "+v"(tid)); const int lane = tid & 63, wid = __builtin_amdgcn_readfirstlane(tid >> 6);
    const int fr = lane & 15, fq = lane >> 4;
    const int g = it & 1, c = (it >> 1) & 63, b = it >> 7;
    LAS bf16* Xt = (LAS bf16*)(lds + SSD_XT); LAS bf16* Bm = (LAS bf16*)(lds + SSD_B); LAS bf16* Cm = (LAS bf16*)(lds + SSD_C);
    LAS float* acsT = (LAS float*)(lds + SSD_TAB); LAS float* dtsT = acsT + 512; LAS float* tot = acsT + 1024; LAS float* rsT = acsT + 1040;
    const float* cw = p.in[3] + (size_t)l * 4 * 1024; const float* cb = p.in[4] + l * 1024;
    { const int cp = tid & 255, th = tid >> 8;
      if (cp < 128) ssd_conv_pair<XR>(PROJ, b, c, th, 256 * g + 2 * cp, cw, cb, Xt, 2 * cp);
      else if (cp < 192) ssd_conv_pair<XP>(PROJ, b, c, th, 512 + 128 * g + 2 * (cp - 128), cw, cb, Bm, 2 * (cp - 128));
      else ssd_conv_pair<XP>(PROJ, b, c, th, 768 + 128 * g + 2 * (cp - 192), cw, cb, Cm, 2 * (cp - 192)); }
    float dtv; const float acs = ssd_cumsum(DT, p.in[6] + l * 8, b, c, g, tid, wid, lane, tot, dtv);
    acsT[tid] = acs; dtsT[tid] = dtv;
    __syncthreads();
    const int w = wid;
    bf16x8 cf[4];
#pragma unroll
    for (int ks = 0; ks < 4; ++ks) cf[ks] = *(const LAS bf16x8*)(Cm + (16 * w + fr) * XP + 32 * ks + 8 * fq);
    f32x4 gt[8];
#pragma unroll
    for (int jt = 0; jt < 8; ++jt) { gt[jt] = (f32x4){0.f, 0.f, 0.f, 0.f};
        if (jt <= w) {
#pragma unroll
            for (int ks = 0; ks < 4; ++ks) gt[jt] = mfma16(*(const LAS bf16x8*)(Bm + (16 * jt + fr) * XP + 32 * ks + 8 * fq), cf[ks], gt[jt]); } }
    __syncthreads();
    LAS bf16* Ys = (LAS bf16*)(lds + SSD_B + wid * SSD_YS_WAVE);
    const int ii = 16 * w + fr; const size_t row = (size_t)b * SEQ + c * 128 + ii;
    float ssq = 0.f;
#pragma unroll 1
    for (int hh = 0; hh < 4; ++hh) {
        const float ai = acsT[hh * 128 + ii];
        const bf16* pp = ST + ((((size_t)b * 64 + c) * 8 + 4 * g + hh) * 64) * 128;
        bf16x8 pf[4][4]; u32x2 zr[4];
#pragma unroll
        for (int pt = 0; pt < 4; ++pt) {
#pragma unroll
            for (int ks = 0; ks < 4; ++ks) pf[pt][ks] = *(const bf16x8*)(pp + (size_t)(16 * pt + fr) * 128 + 32 * ks + 8 * fq);
            zr[pt] = *(const u32x2*)(PROJ + row * PJ + C_Z + 256 * g + 64 * hh + 16 * pt + 4 * fq); }
        f32x4 y[4];
#pragma unroll
        for (int pt = 0; pt < 4; ++pt) y[pt] = (f32x4){0.f, 0.f, 0.f, 0.f};
#pragma unroll
        for (int u = 0; u < 4; ++u) {
            if (2 * u <= w) {
                float sv[8];
#pragma unroll
                for (int q = 0; q < 2; ++q) { const int jt = 2 * u + q; const f32x4 aj = *(const LAS f32x4*)(acsT + hh * 128 + 16 * jt + 4 * fq), dj = *(const LAS f32x4*)(dtsT + hh * 128 + 16 * jt + 4 * fq);
#pragma unroll
                    for (int v = 0; v < 4; ++v) { const int j = 16 * jt + 4 * fq + v; sv[4 * q + v] = (j <= ii) ? gt[jt][v] * fexp(fminf(ai - aj[v], 0.f)) * dj[v] : 0.f; } }
                u32x4 pw; pw.x = pk2(sv[0], sv[1]); pw.y = pk2(sv[2], sv[3]); pw.z = pk2(sv[4], sv[5]); pw.w = pk2(sv[6], sv[7]);
                const bf16x8 pb = __builtin_bit_cast(bf16x8, pw);
#pragma unroll
                for (int pt = 0; pt < 4; ++pt) { const LAS bf16* xr = Xt + (32 * u + 4 * fq + (fr >> 2)) * XR + 64 * hh + 16 * pt + 4 * (fr & 3);
                    y[pt] = mfma16(cat8(lds_tr16(xr), lds_tr16(xr + 16 * XR)), pb, y[pt]); }
            }
        }
        const float ea = fexp(ai); const float dsk = p.in[7][l * 8 + 4 * g + hh];
#pragma unroll
        for (int pt = 0; pt < 4; ++pt) { f32x4 yo = {0.f, 0.f, 0.f, 0.f};
#pragma unroll
            for (int ks = 0; ks < 4; ++ks) yo = mfma16(pf[pt][ks], cf[ks], yo);
            const int ch = 64 * hh + 16 * pt + 4 * fq;
            const float zv[4] = {bflo(zr[pt].x), bfhi(zr[pt].x), bflo(zr[pt].y), bfhi(zr[pt].y)};
            float t[4]; const u32x2 xw = *(const LAS u32x2*)(Xt + ii * XR + ch); const float xq[4] = {bflo(xw.x), bfhi(xw.x), bflo(xw.y), bfhi(xw.y)};
#pragma unroll
            for (int v = 0; v < 4; ++v) { t[v] = (y[pt][v] + ea * yo[v] + dsk * xq[v]) * siluf_(zv[v]); ssq += t[v] * t[v]; }
            u32x2 wv; wv.x = pk2(t[0], t[1]); wv.y = pk2(t[2], t[3]); *(LAS u32x2*)(Ys + fr * YP + ch) = wv; }
    }
    ssq += __shfl_xor(ssq, 16); ssq += __shfl_xor(ssq, 32);
    if (fq == 0) rsT[ii] = __builtin_amdgcn_rsqf(ssq * (1.0f / 256.0f) + 1e-5f);
    asm volatile("" ::: "memory");
    const float* nw = p.in[8] + l * 512 + 256 * g + 8 * (lane & 31);
    const f32x4 n0 = *(const f32x4*)nw, n1 = *(const f32x4*)(nw + 4);
    bf16* mbase = MIX + ((size_t)b * SEQ + c * 128 + 16 * w) * DMIX + 512 + 256 * g + 8 * (lane & 31);
#pragma unroll
    for (int q = 0; q < 8; ++q) { const int tok = 2 * q + (lane >> 5); const u32x4 yr = *(const LAS u32x4*)(Ys + tok * YP + 8 * (lane & 31)); const float rstd = rsT[16 * w + tok];
        u32x4 o; o.x = pk2(bflo(yr.x) * rstd * n0[0], bfhi(yr.x) * rstd * n0[1]); o.y = pk2(bflo(yr.y) * rstd * n0[2], bfhi(yr.y) * rstd * n0[3]);
        o.z = pk2(bflo(yr.z) * rstd * n1[0], bfhi(yr.z) * rstd * n1[1]); o.w = pk2(bflo(yr.w) * rstd * n1[2], bfhi(yr.w) * rstd * n1[3]);
        *(u32x4*)(mbase + (size_t)tok * DMIX) = o; }
    __syncthreads();
}
static_assert(SSD_END <= LDS_BYTES, "SSD LDS map");
constexpr int LR_XP = 72, LR_AP = 68, LR_WAVE_BYTES = 16 * LR_XP * 2 + 2 * 16 * LR_AP * 4;
__device__ __forceinline__ void lru_local_item(LAS unsigned char* lds, const Params& p, int l, const bf16* PROJ, bf16* MIX, bf16* PL, float* AGA, float* AGH, int it, int tid) {
    asm volatile("" : "+v"(tid));
    const int lane = tid & 63, wid = __builtin_amdgcn_readfirstlane(tid >> 6), fr = lane & 15, fq = lane >> 4;
    const int kc = it & 127, b = it >> 7, ch = tid, cc = lane;
    LAS bf16* xcb = (LAS bf16*)(lds + wid * LR_WAVE_BYTES);
    LAS float* arL = (LAS float*)(lds + wid * LR_WAVE_BYTES + 16 * LR_XP * 2); LAS float* aiL = arL + 16 * LR_AP;
    bf16x8 wf[2][4][2];
#pragma unroll
    for (int mat = 0; mat < 2; ++mat) { const float* wb = p.in[mat == 0 ? 11 : 13] + (size_t)l * 32768 + (size_t)wid * 4096 + fr;
#pragma unroll
        for (int ks = 0; ks < 2; ++ks)
#pragma unroll
            for (int ct = 0; ct < 4; ++ct) { const float* wp = wb + (32 * ks + 8 * fq) * 64 + 16 * ct; u32x4 w;
                w.x = pk2(wp[0], wp[64]); w.y = pk2(wp[128], wp[192]); w.z = pk2(wp[256], wp[320]); w.w = pk2(wp[384], wp[448]); wf[mat][ct][ks] = __builtin_bit_cast(bf16x8, w); } }
    const float* cwp = p.in[9] + (size_t)l * 4 * 512 + ch; const float w0 = cwp[0], w1 = cwp[512], w2 = cwp[1024], w3 = cwp[1536], cb = p.in[10][l * 512 + ch];
    const float ba = p.in[12][l * 512 + ch], bx = p.in[14][l * 512 + ch], sp8 = -8.0f * softplusf(-p.in[15][l * 512 + ch]);
    const size_t row0 = (size_t)b * SEQ + (size_t)kc * 64;
    const bf16* src = PROJ + row0 * PJ + C_XL + ch;
    float xm3 = 0.f, xm2 = 0.f, xm1 = 0.f;
    if (kc > 0) { xm3 = bf2f(*(src - 3 * (ptrdiff_t)PJ)); xm2 = bf2f(*(src - 2 * (ptrdiff_t)PJ)); xm1 = bf2f(*(src - (ptrdiff_t)PJ)); }
    bf16 rawn[16];
#pragma unroll
    for (int e = 0; e < 16; ++e) rawn[e] = src[(size_t)e * PJ];
    float h = 0.f, P = 1.f;
#pragma unroll 1
    for (int sb = 0; sb < 4; ++sb) {
        float xc[16];
#pragma unroll
        for (int e = 0; e < 16; ++e) { const float x = bf2f(rawn[e]); const float y = cb + w0 * xm3 + w1 * xm2 + w2 * xm1 + w3 * x; xm3 = xm2; xm2 = xm1; xm1 = x; xc[e] = y; xcb[e * LR_XP + cc] = (bf16)f2bf(y); }
        if (sb < 3) {
#pragma unroll
            for (int e = 0; e < 16; ++e) rawn[e] = src[(size_t)(16 * (sb + 1) + e) * PJ]; }
        asm volatile("" ::: "memory");
        f32x4 accr[4], acci[4];
#pragma unroll
        for (int ct = 0; ct < 4; ++ct) { accr[ct] = (f32x4){0.f, 0.f, 0.f, 0.f}; acci[ct] = (f32x4){0.f, 0.f, 0.f, 0.f}; }
#pragma unroll
        for (int ks = 0; ks < 2; ++ks) { const bf16x8 a = *(const LAS bf16x8*)(xcb + fr * LR_XP + 32 * ks + 8 * fq);
#pragma unroll
            for (int ct = 0; ct < 4; ++ct) { accr[ct] = mfma16(a, wf[0][ct][ks], accr[ct]); acci[ct] = mfma16(a, wf[1][ct][ks], acci[ct]); } }
#pragma unroll
        for (int ct = 0; ct < 4; ++ct)
#pragma unroll
            for (int v = 0; v < 4; ++v) { arL[(4 * fq + v) * LR_AP + 16 * ct + fr] = accr[ct][v]; aiL[(4 * fq + v) * LR_AP + 16 * ct + fr] = acci[ct][v]; }
        asm volatile("" ::: "memory");
#pragma unroll
        for (int t = 0; t < 16; ++t) {
            const float ar = arL[t * LR_AP + cc] + ba, ai = aiL[t * LR_AP + cc] + bx;
            const float rg = sigmoidf_(ar), ig = sigmoidf_(ai), la = sp8 * rg, a = fexp(la), x2 = 2.0f * la;
            const float om_small = -x2 * (1.0f + x2 * (0.5f + x2 * (0.16666667f + x2 * (0.041666668f + x2 * (0.0083333338f + x2 * 0.0013888889f)))));
            const float om = (x2 > -0.25f) ? om_small : 1.0f - a * a;
            const float u = __builtin_amdgcn_sqrtf(om) * (ig * xc[t]);
            h = a * h + u; P *= a;
            const size_t row = row0 + 16 * sb + t;
            MIX[row * DMIX + 1024 + ch] = (bf16)f2bf(h); PL[row * 512 + ch] = (bf16)f2bf(P);
        }
        asm volatile("" ::: "memory");
    }
    AGA[((size_t)b * 128 + kc) * 512 + ch] = P; AGH[((size_t)b * 128 + kc) * 512 + ch] = h;
    __syncthreads();
}
__device__ __forceinline__ void lru_final_item(const bf16* PROJ, bf16* MIX, const bf16* PL, const float* AGH, int it, int tid) {
    asm volatile("" : "+v"(tid));
    const int kc = it & 127, b = it >> 7, ch = 2 * (tid & 255), th = tid >> 8;
    const f32x2 carry = *(const f32x2*)(AGH + ((size_t)b * 128 + kc) * 512 + ch);
    const size_t row0 = (size_t)b * SEQ + (size_t)kc * 64 + 32 * th;
    { constexpr int tb = 0;
        unsigned hl[32], pv[32], gv[32];
#pragma unroll
        for (int e = 0; e < 32; ++e) { const size_t row = row0 + 16 * tb + e; hl[e] = *(const unsigned*)(MIX + row * DMIX + 1024 + ch); pv[e] = *(const unsigned*)(PL + row * 512 + ch); gv[e] = *(const unsigned*)(PROJ + row * PJ + C_GL + ch); }
#pragma unroll
        for (int e = 0; e < 32; ++e) { const size_t row = row0 + 16 * tb + e;
            const float o0 = (bflo(hl[e]) + bflo(pv[e]) * carry.x) * gelu_tanh(bflo(gv[e])), o1 = (bfhi(hl[e]) + bfhi(pv[e]) * carry.y) * gelu_tanh(bfhi(gv[e]));
            *(unsigned*)(MIX + row * DMIX + 1024 + ch) = pk2(o0, o1); }
    }
}
__device__ __forceinline__ void scans_phase(bf16* ST, const float* CD, const float* AGA, float* AGH, int gtid, int gthreads, int gw, int NGW, int lane) {
    for (int e = gtid; e < 2 * 8 * 64 * 128; e += gthreads) {
        const int b = e >> 16, rem = e & 65535, h = rem >> 13;
        bf16* sp = ST + (size_t)b * 64 * 65536 + rem; const float* cd = CD + (size_t)b * 64 * 8 + h;
        float carry = 0.f;
#pragma unroll 1
        for (int c0 = 0; c0 < 64; c0 += 32) {
            bf16 s[32]; float d[32];
#pragma unroll
            for (int q = 0; q < 32; ++q) { s[q] = sp[(size_t)(c0 + q) * 65536]; d[q] = cd[(c0 + q) * 8]; }
#pragma unroll
            for (int q = 0; q < 32; ++q) { sp[(size_t)(c0 + q) * 65536] = (bf16)f2bf(carry); carry = d[q] * carry + bf2f(s[q]); }
        }
    }
    for (int e = gw; e < 2 * 512; e += NGW) {
        const int b = e >> 9, ch = e & 511;
        const float* ap = AGA + (size_t)b * 128 * 512 + ch; float* hp = AGH + (size_t)b * 128 * 512 + ch;
        const float a0 = ap[(size_t)(2 * lane) * 512], a1 = ap[(size_t)(2 * lane + 1) * 512], h0 = hp[(size_t)(2 * lane) * 512], h1 = hp[(size_t)(2 * lane + 1) * 512];
        float A = a0 * a1, H = a1 * h0 + h1;
#pragma unroll
        for (int dd = 1; dd < 64; dd <<= 1) { const float Ap = __shfl_up(A, dd), Hp = __shfl_up(H, dd); if (lane >= dd) { H = A * Hp + H; A = A * Ap; } }
        float cin = __shfl_up(H, 1); if (lane == 0) cin = 0.f;
        hp[(size_t)(2 * lane) * 512] = cin; hp[(size_t)(2 * lane + 1) * 512] = a0 * cin + h0;
    }
}
#define XB_TMO      128
#define XB_XCNT(j)  (256  + 64 * (j))
#define XB_XSUB(j)  (1280 + 64 * (j))
#define XB_XGEN(j)  (2304 + 64 * (j))
#define XB_TOP      3328
#define XB_TOPGEN   3392
#define XCD_BAR_WORDS 3456
#define XB_SPIN_CAP (1u << 18)

__device__ __forceinline__ unsigned xb_ld(unsigned* p)              { return __hip_atomic_load(p, __ATOMIC_RELAXED, __HIP_MEMORY_SCOPE_AGENT); }
__device__ __forceinline__ unsigned xb_add(unsigned* p, unsigned v) { return __hip_atomic_fetch_add(p, v, __ATOMIC_RELAXED, __HIP_MEMORY_SCOPE_AGENT); }
__device__ __forceinline__ unsigned xb_xcc_id() { return (unsigned)__builtin_amdgcn_s_getreg((3 << 11) | 20) & 0xFu; }
#define XB_SPIN(cond, bar) do { unsigned _sp = 0; while (cond) { __builtin_amdgcn_s_sleep(1); \
    if ((++_sp & 255u) == 0u) { if (xb_ld(&(bar)[XB_TMO])) break; if (_sp > XB_SPIN_CAP) { atomicAdd(&(bar)[XB_TMO], 1u); break; } } } } while (0)

struct XcdBarrier {
    unsigned* bar; unsigned x;
    volatile LAS unsigned* st;
};

__device__ __forceinline__ XcdBarrier xcd_barrier_post(unsigned* bar, volatile LAS unsigned* st) {
    XcdBarrier b; b.bar = bar; b.x = xb_xcc_id(); b.st = st;
    if (threadIdx.x == 0) (void)xb_add(&bar[XB_XCNT(b.x)], 1u);
    return b;
}
__device__ __forceinline__ void xcd_barrier_complete(unsigned* bar, unsigned x, unsigned& nloc, unsigned& nx) {
    const unsigned G = gridDim.x * gridDim.y * gridDim.z;
    unsigned sum, cnt, mine, sp = 0u;
    for (;;) {
        sum = 0u; cnt = 0u; mine = 0u;
#pragma unroll
        for (unsigned j = 0; j < 16; ++j) { const unsigned c = xb_ld(&bar[XB_XCNT(j)]); sum += c; cnt += (c > 0u) ? 1u : 0u; mine = (j == x) ? c : mine; }
        if (sum == G) break;
        __builtin_amdgcn_s_sleep(1);
        if ((++sp & 255u) == 0u) { if (xb_ld(&bar[XB_TMO])) break; if (sp > XB_SPIN_CAP) { atomicAdd(&bar[XB_TMO], 1u); break; } }
    }
    nloc = mine > 0u ? mine : 1u; nx = cnt > 0u ? cnt : 1u;
}

__device__ __forceinline__ void xcd_barrier(const XcdBarrier& b) {
    asm volatile("s_waitcnt vmcnt(0)" ::: "memory");
    __syncthreads();
    if (threadIdx.x == 0) {
        unsigned* bar = b.bar;
        __builtin_amdgcn_s_waitcnt(0);
        unsigned nloc = b.st[0], nx = b.st[1];
        if (nloc == 0u) { xcd_barrier_complete(bar, b.x, nloc, nx); b.st[0] = nloc; b.st[1] = nx; }
        const unsigned old = xb_add(&bar[XB_XSUB(b.x)], 1u);
        const unsigned gen = old / nloc;
        if (old + 1u == (gen + 1u) * nloc) {
            __builtin_amdgcn_fence(__ATOMIC_RELEASE, "agent");
            asm volatile("s_waitcnt vmcnt(0)" ::: "memory");
            const unsigned og = xb_add(&bar[XB_TOP], 1u);
            const unsigned tg = og / nx;
            if (og + 1u == (tg + 1u) * nx) xb_add(&bar[XB_TOPGEN], 1u);
            else XB_SPIN(xb_ld(&bar[XB_TOPGEN]) == tg, bar);
            __builtin_amdgcn_fence(__ATOMIC_ACQUIRE, "agent");
            xb_add(&bar[XB_XGEN(b.x)], 1u);
            asm volatile("s_waitcnt vmcnt(0)" ::: "memory");
        } else {
            XB_SPIN(xb_ld(&bar[XB_XGEN(b.x)]) == gen, bar);
            __builtin_amdgcn_fence(__ATOMIC_ACQUIRE, "agent");
            asm volatile("s_waitcnt vmcnt(0)" ::: "memory");
        }
    }
    __syncthreads();
}

__global__ void __launch_bounds__(NTHR, 2) hybrid_fwd(Params p) {
    extern __shared__ __attribute__((aligned(16))) unsigned char lds_raw[];
    LAS unsigned char* lds = (LAS unsigned char*)lds_raw;
    volatile LAS unsigned* bst = (volatile LAS unsigned*)(lds + LDS_BYTES - 1024);
    if (threadIdx.x == 0) { bst[0] = 0u; bst[1] = 0u; }
    __syncthreads();
    const XcdBarrier xbar = xcd_barrier_post((unsigned*)p.ws, bst);
#define GRID_BAR() xcd_barrier(xbar)
    const int G = gridDim.x, bid = blockIdx.x, NGW = G * 8;
#ifdef DIAG_A
    LAS unsigned long long* dts = (LAS unsigned long long*)(lds + LDS_BYTES - 512);
    if (threadIdx.x == 0) { for (int k = 1; k < 32; ++k) dts[k] = 0ull; dts[0] = __builtin_amdgcn_s_memrealtime(); }
#define STAMP(k) do { if (threadIdx.x == 0) { const unsigned long long t_ = __builtin_amdgcn_s_memrealtime(); dts[1 + (k)] += t_ - dts[0]; dts[0] = t_; } } while (0)
#else
#define STAMP(k) do {} while (0)
#endif
#define FRESH_TID() int tid = threadIdx.x; asm volatile("" : "+v"(tid)); const int lane = tid & 63, wave = __builtin_amdgcn_readfirstlane(tid >> 6), gw = bid * 8 + wave; (void)lane; (void)gw;
    unsigned char* ws = p.ws;
    float* DT = (float*)(ws + WS_DT); float* LSE = (float*)(ws + WS_LSE); float* AGA = (float*)(ws + WS_AGA); float* AGH = (float*)(ws + WS_AGH); float* CD = (float*)(ws + WS_CD); float* RSP = (float*)(ws + WS_RSP);
    bf16* WinT = (bf16*)(ws + WS_WIN); bf16* WdT = (bf16*)(ws + WS_WD);
    bf16* XN = (bf16*)(ws + WS_XN); bf16* ST = (bf16*)(ws + WS_ST); bf16* PL = (bf16*)(ws + WS_PL);
    bf16* PROJ = (bf16*)(ws + WS_PROJ); bf16* ACT = (bf16*)(ws + WS_PROJ); bf16* MIX = (bf16*)(ws + WS_MIX);
#pragma unroll 1
    for (int l = 0; l < DEPTH; ++l) {
        bf16* XB1 = (bf16*)(ws + WS_PROJ + 92 * MiB); bf16* XB2 = (bf16*)p.out;
        bf16* WoutT = (bf16*)(ws + (l == 0 ? WS_WOUT : WS_WOUT1)); bf16* WguT = (bf16*)(ws + (l == 0 ? WS_WGU : WS_WGU1));
        const WtDst wd0{(bf16*)(ws + WS_WIN), (bf16*)(ws + WS_WOUT), (bf16*)(ws + WS_WGU), (bf16*)(ws + WS_WD)}, wd1{(bf16*)(ws + WS_WIN), (bf16*)(ws + WS_WOUT1), (bf16*)(ws + WS_WGU1), (bf16*)(ws + WS_WD)};
        { FRESH_TID();
        if (l == 0) weights_phase(p, 0, wd0, 0, WT_IO, lds, gw, NGW, wave, lane);
        if (l == 0) norm_dt_phase<false>(p.in[0], XN, p.in[1] + l * DM, p.in[2] + (size_t)l * DM * INC, p.in[5] + l * 8, DT, gw, NGW, lane, lds, tid);
        else norm_dt_phase<true>(XB2, XN, p.in[1] + l * DM, p.in[2] + (size_t)l * DM * INC, p.in[5] + l * 8, DT, gw, NGW, lane, lds, tid);
        }
        STAMP(0); GRID_BAR(); STAMP(1);
        { pg8::Gemm g{XN, WinT, NTOK, PJ, DM}; pg8::StaticOrder S; S.init(NTOK, PJ, G, bid); pg8::EpiBf16<0> E{PROJ, PJ, nullptr, 0, 0, 1.f};
          pg8::gemm_phase<pg8::EpiBf16<0>, pg8::StaticOrder, true, true>(lds, g, S, E); }
        STAMP(2); GRID_BAR(); STAMP(3);
        { FRESH_TID();
        int it = bid;
        for (; it < 512; it += G) {
            if (it < 256) { lru_local_item(lds, p, l, PROJ, MIX, PL, AGA, AGH, it, tid); STAMP(4); }
            else { ssd_states_item(lds, p, l, PROJ, DT, ST, CD, it - 256, tid); STAMP(5); }
        }
        attn_phase(lds, PROJ, MIX, LSE, 0, bid, G, tid); STAMP(6);
        }
        GRID_BAR(); STAMP(7);
        { FRESH_TID();
        scans_phase(ST, CD, AGA, AGH, bid * NTHR + tid, G * NTHR, gw, NGW, lane); STAMP(8);
        attn_phase(lds, PROJ, MIX, LSE, 1, bid, G, tid);
        if (l == 0) weights_phase(p, 0, wd0, WT_IO, WT_ALL, lds, gw, NGW, wave, lane);
        }
        STAMP(9); GRID_BAR(); STAMP(10);
        { FRESH_TID();
        int it = bid;
        for (; it < 512; it += G) {
            if (it < 256) { ssd_out_item(lds, p, l, PROJ, DT, ST, MIX, it, tid); STAMP(11); }
            else { lru_final_item(PROJ, MIX, PL, AGH, it - 256, tid); STAMP(12); }
        }
        attn_phase(lds, PROJ, MIX, LSE, 2, bid, G, tid); STAMP(13);
        }
        GRID_BAR(); STAMP(14);
        { pg8::Gemm g{MIX, WoutT, NTOK, DM, DMIX}; pg8::StaticOrder S; S.init(NTOK, DM, G, bid); if (l == 0) { pg8::EpiResBf<true> E{p.in[0], XB1, DM, RSP}; pg8::gemm_phase<pg8::EpiResBf<true>, pg8::StaticOrder, true, true>(lds, g, S, E); }
          else { pg8::EpiResBf<false> E{XB2, XB1, DM, RSP}; pg8::gemm_phase<pg8::EpiResBf<false>, pg8::StaticOrder, true, true>(lds, g, S, E); } }
        STAMP(15); GRID_BAR(); STAMP(16);
        { pg8::Gemm g{XB1, WguT, NTOK, 2 * DFF, DM}; pg8::StaticOrder S; S.init(NTOK, 2 * DFF, G, bid); pg8::EpiSwiGLU E{ACT, DFF, RSP};
          pg8::gemm_phase<pg8::EpiSwiGLU, pg8::StaticOrder, true, true>(lds, g, S, E); }
        {
          const int nun = (NTOK / 256) * (2 * DFF / 256), rounds = (nun + G - 1) / G, nbusy = nun - (rounds - 1) * G;
          if (nbusy < G && bid >= nbusy) { FRESH_TID(); const int gw2 = (bid - nbusy) * 8 + wave, ngw2 = (G - nbusy) * 8;
              if (l == 0) weights_phase(p, 1, wd1, 0, WT_EARLY, lds, gw2, ngw2, wave, lane); else weights_phase(p, 1, wd1, WT_EARLY, WT_ALL, lds, gw2, ngw2, wave, lane); }
          else if (nbusy >= G) { FRESH_TID(); if (l == 0) weights_phase(p, 1, wd1, 0, WT_EARLY, lds, gw, NGW, wave, lane); else weights_phase(p, 1, wd1, WT_EARLY, WT_ALL, lds, gw, NGW, wave, lane); } }
        STAMP(19); GRID_BAR(); STAMP(20);
        { pg8::Gemm g{ACT, WdT, NTOK, DM, DFF}; pg8::StaticOrder S; S.init(NTOK, DM, G, bid); pg8::EpiResBf<false> E{XB1, l == 0 ? XB2 : XB1, DM, nullptr};
          pg8::gemm_phase<pg8::EpiResBf<false>, pg8::StaticOrder, true, true>(lds, g, S, E); }
        STAMP(21); GRID_BAR(); STAMP(22);
    }
    { FRESH_TID(); final_norm_phase((const bf16*)(ws + WS_PROJ + 92 * MiB), p.out, p.in[21], gw, NGW, lane); }
    STAMP(23);
#ifdef DIAG_A
    if (bid == 0) {
        __threadfence(); __syncthreads();
        const float ta = (float)dts[1 + DIAG_A] * 0.01f, tb = (float)dts[1 + DIAG_B] * 0.01f;
        const float Ea = sqrtf(0.16384f * ta);
        atomicAdd(p.out + threadIdx.x, Ea); atomicAdd(p.out + 512 + threadIdx.x, Ea);
        if (threadIdx.x == 0) atomicAdd(p.out + 1024, tb * 0.1f);
    }
#endif
}

extern "C" void kernel_launch(void* const* d_in, const int* in_sizes, int n_in, void* d_out, int out_size, void* d_ws, size_t ws_size, hipStream_t stream) {
    static int grid = 0;
    if (grid == 0) {
        if (n_in != 22 || out_size != NTOK * DM || ws_size < WS_END) { fprintf(stderr, "kernel_launch: unexpected shapes (n_in %d out %d ws %zu)\n", n_in, out_size, ws_size); grid = -1; return; }
        int dev = 0, cus = 0, per_cu = 0;
        hipGetDevice(&dev); hipDeviceGetAttribute(&cus, hipDeviceAttributeMultiprocessorCount, dev);
        if (hipFuncSetAttribute((const void*)hybrid_fwd, hipFuncAttributeMaxDynamicSharedMemorySize, LDS_BYTES) != hipSuccess) { fprintf(stderr, "kernel_launch: hipFuncSetAttribute failed\n"); grid = -1; return; }
        if (hipOccupancyMaxActiveBlocksPerMultiprocessor(&per_cu, (const void*)hybrid_fwd, NTHR, LDS_BYTES) != hipSuccess || per_cu < 1) { fprintf(stderr, "kernel_launch: occupancy query failed (%d)\n", per_cu); grid = -1; return; }
        grid = cus * per_cu;
    }
    if (grid < 0) return;
    if (hipMemsetAsync(d_ws, 0, 16384, stream) != hipSuccess) { fprintf(stderr, "kernel_launch: memset failed\n"); return; }
    Params p{};
    for (int i = 0; i < 22; ++i) p.in[i] = (const float*)d_in[i];
    p.out = (float*)d_out; p.ws = (unsigned char*)d_ws;
    void* args[] = {&p};
    hipError_t e = hipLaunchCooperativeKernel((const void*)hybrid_fwd, dim3(grid), dim3(NTHR), args, LDS_BYTES, stream);
    if (e != hipSuccess) fprintf(stderr, "cooperative launch failed: %s (grid %d)\n", hipGetErrorString(e), grid);
}
```
